# Optimizing an MI355X kernel written in HIP

```python
import math
import jax
import jax.numpy as jnp
from jax import lax
import numpy as np

D_MODEL = 1024
BATCH = 8
SEQ = 8192
DEPTH = 4
DEC_BATCH = 2
DEC_SEQ = 8192
PAST_LEN = 128

PLE_DIM = 256
GRID_W = 64
HEAD_DIM = 64
BRANCH_W = 256
N_BRANCH = 4
EPS = 1e-6
NEG_INF = -1e30

MLA_HEADS = 4
MLA_Q_RANK = 256
MLA_KV_RANK = 128
MLA_NOPE = 64
MLA_ROPE = 32
MLA_V = 64
ROPE_THETA = 10000.0
MLA_QBLOCK = 128

DIL_PAIRS = ((128, 1), (512, 4), (2048, 16))
DIL_SLOTS = 4
DIL_HEADS = DIL_SLOTS * len(DIL_PAIRS)
DIL_BLOCK = 64

SWA_Q_HEADS = 4
SWA_KV_HEADS = 2
SWA_WINDOW = 128
SWA_BLOCK = 128

NA_HEADS = 4
NA_ROWS_MAX = 8
NA_COLS = 16
NA_QCOLS = 16
NA_KCOLS = 32

REL_BUCKETS = 32
REL_MAX_DIST = 1024
REL_HEADS = DIL_HEADS + SWA_Q_HEADS

D_FF = 2816
CONV_W = 3

A_COLS = MLA_Q_RANK + MLA_KV_RANK + MLA_ROPE
B_COLS = 3 * DIL_HEADS * HEAD_DIM
C_COLS = (SWA_Q_HEADS + 2 * SWA_KV_HEADS) * HEAD_DIM
D_COLS = 3 * NA_HEADS * HEAD_DIM
IN_COLS = A_COLS + B_COLS + C_COLS + D_COLS

kernel_name = 'hybrid_parallel_encoder'


def rmsnorm(x, g):
    xf = x.astype(jnp.float32)
    y = xf * lax.rsqrt(jnp.mean(xf * xf, -1, keepdims=True) + EPS)
    return (y * g.astype(jnp.float32)).astype(x.dtype)


def t5_bucket(rel):
    nb = REL_BUCKETS // 2
    max_exact = nb // 2
    ret = jnp.where(rel > 0, nb, 0)
    n = jnp.abs(rel)
    nf = jnp.maximum(n, 1).astype(jnp.float32)
    large = max_exact + (jnp.log(nf / max_exact) / math.log(REL_MAX_DIST / max_exact) * (nb - max_exact)).astype(jnp.int32)
    large = jnp.minimum(large, nb - 1)
    return ret + jnp.where(n < max_exact, n, large)


def band_offsets(block):
    return np.arange(3 * block)[None, :] - block - np.arange(block)[:, None]


def banded_attention(q, k, v, bias, window, block, sink=None):
    n, L, hq, dh = q.shape
    hkv = k.shape[2]
    g = hq // hkv
    nb = -(-L // block)
    lp = nb * block
    pad = lp - L
    qb = jnp.pad(q, ((0, 0), (0, pad), (0, 0), (0, 0))).reshape(n, nb, block, hkv, g, dh)

    def key_window(t):
        tb = jnp.pad(t, ((0, 0), (block, block + pad), (0, 0), (0, 0))).reshape(n, nb + 2, block, hkv, dh)
        return jnp.concatenate([tb[:, :-2], tb[:, 1:-1], tb[:, 2:]], axis=2)

    kb = key_window(k)
    vb = key_window(v)
    s = jnp.einsum('nbqhgd,nbkhd->nbhgqk', qb, kb, preferred_element_type=jnp.float32) * (dh ** -0.5)
    s = s + bias.astype(jnp.float32).reshape(hkv, g, block, 3 * block)
    off = band_offsets(block)
    kpos = np.arange(nb)[:, None, None] * block + np.arange(block)[None, :, None] + off[None]
    valid = (np.abs(off)[None] <= window) & (kpos >= 0) & (kpos < L)
    s = jnp.where(valid[None, :, None, None], s, NEG_INF)
    m = jnp.max(s, -1, keepdims=True)
    lse = m + jnp.log(jnp.sum(jnp.exp(s - m), -1, keepdims=True))
    if sink is not None:
        lse = jnp.logaddexp(lse, sink.astype(jnp.float32).reshape(hkv, g, 1, 1))
    p = jnp.exp(s - lse)
    o = jnp.einsum('nbhgqk,nbkhd->nbqhgd', p.astype(v.dtype), vb).reshape(n, lp, hq, dh)[:, :L]
    lse = jnp.transpose(lse[..., 0], (0, 1, 4, 2, 3)).reshape(n, lp, hq)[:, :L]
    return o, lse


def rope_tables(seq):
    inv = ROPE_THETA ** (-jnp.arange(0, MLA_ROPE, 2, dtype=jnp.float32) / MLA_ROPE)
    ang = jnp.arange(seq, dtype=jnp.float32)[:, None] * inv[None]
    return jnp.cos(ang), jnp.sin(ang)


def apply_rope(x, cos, sin):
    x1, x2 = jnp.split(x, 2, -1)
    c = cos.astype(x.dtype)
    s = sin.astype(x.dtype)
    return jnp.concatenate([x1 * c - x2 * s, x1 * s + x2 * c], -1)


def mla_attention(za, q_norm, kv_norm, w_q_up, w_kv_up):
    bsz, seq = za.shape[:2]
    cq = rmsnorm(za[..., :MLA_Q_RANK], q_norm)
    ckv = rmsnorm(za[..., MLA_Q_RANK:MLA_Q_RANK + MLA_KV_RANK], kv_norm)
    k_rope = za[..., MLA_Q_RANK + MLA_KV_RANK:]
    q = (cq @ w_q_up).reshape(bsz, seq, MLA_HEADS, MLA_NOPE + MLA_ROPE)
    kv = (ckv @ w_kv_up).reshape(bsz, seq, MLA_HEADS, MLA_NOPE + MLA_V)
    cos, sin = rope_tables(seq)
    q = jnp.concatenate([q[..., :MLA_NOPE], apply_rope(q[..., MLA_NOPE:], cos[:, None], sin[:, None])], -1)
    k_rope = apply_rope(k_rope, cos, sin)
    k = jnp.concatenate([kv[..., :MLA_NOPE], jnp.broadcast_to(k_rope[:, :, None], (bsz, seq, MLA_HEADS, MLA_ROPE))], -1)
    v = kv[..., MLA_NOPE:]
    scale = (MLA_NOPE + MLA_ROPE) ** -0.5
    nq = seq // MLA_QBLOCK
    qb = jnp.moveaxis(q.reshape(bsz, nq, MLA_QBLOCK, MLA_HEADS, MLA_NOPE + MLA_ROPE), 1, 0)

    def query_block(qi):
        s = jnp.einsum('bqhd,bkhd->bhqk', qi, k, preferred_element_type=jnp.float32) * scale
        p = jax.nn.softmax(s, axis=-1)
        return jnp.einsum('bhqk,bkhd->bqhd', p.astype(v.dtype), v)

    o = lax.map(query_block, qb)
    return jnp.moveaxis(o, 0, 1).reshape(bsz, seq, MLA_HEADS * MLA_V)


def dilated_attention(zb, rel_table):
    bsz, seq = zb.shape[:2]
    t = zb.reshape(bsz, seq, len(DIL_PAIRS), 3, DIL_SLOTS, HEAD_DIM)
    off = band_offsets(DIL_BLOCK)
    outs = []
    lses = []
    for gi, (window, dil) in enumerate(DIL_PAIRS):
        half = window // (2 * dil)
        sub = seq // dil

        def to_sub(a):
            return a.reshape(bsz, sub, dil, DIL_SLOTS, HEAD_DIM).transpose(0, 2, 1, 3, 4).reshape(bsz * dil, sub, DIL_SLOTS, HEAD_DIM)

        q = to_sub(t[:, :, gi, 0])
        k = to_sub(t[:, :, gi, 1])
        v = to_sub(t[:, :, gi, 2])
        bias = rel_table[t5_bucket(jnp.asarray(off * dil))][..., gi * DIL_SLOTS:(gi + 1) * DIL_SLOTS]
        o, lse = banded_attention(q, k, v, jnp.moveaxis(bias, -1, 0), half, DIL_BLOCK)
        outs.append(o.reshape(bsz, dil, sub, DIL_SLOTS, HEAD_DIM).transpose(0, 2, 1, 3, 4).reshape(bsz, seq, DIL_SLOTS, HEAD_DIM))
        lses.append(lse.reshape(bsz, dil, sub, DIL_SLOTS).transpose(0, 2, 1, 3).reshape(bsz, seq, DIL_SLOTS))
    w = jax.nn.softmax(jnp.stack(lses, 0), axis=0)
    o = w[0][..., None].astype(outs[0].dtype) * outs[0]
    for gi in range(1, len(DIL_PAIRS)):
        o = o + w[gi][..., None].astype(outs[gi].dtype) * outs[gi]
    return o.reshape(bsz, seq, DIL_SLOTS * HEAD_DIM)


def window_gqa(zc, rel_table, sink):
    bsz, seq = zc.shape[:2]
    nq = SWA_Q_HEADS * HEAD_DIM
    nk = SWA_KV_HEADS * HEAD_DIM
    q = zc[..., :nq].reshape(bsz, seq, SWA_Q_HEADS, HEAD_DIM)
    k = zc[..., nq:nq + nk].reshape(bsz, seq, SWA_KV_HEADS, HEAD_DIM)
    v = zc[..., nq + nk:].reshape(bsz, seq, SWA_KV_HEADS, HEAD_DIM)
    bias = rel_table[t5_bucket(jnp.asarray(band_offsets(SWA_BLOCK)))][..., DIL_HEADS:]
    o, _ = banded_attention(q, k, v, jnp.moveaxis(bias, -1, 0), SWA_WINDOW, SWA_BLOCK, sink)
    return o.reshape(bsz, seq, SWA_Q_HEADS * HEAD_DIM)


def na_col_tables():
    ncb = GRID_W // NA_QCOLS
    starts = np.clip(np.arange(ncb) * NA_QCOLS - NA_COLS // 2, 0, GRID_W - NA_KCOLS)
    qc = np.arange(GRID_W).reshape(ncb, NA_QCOLS)
    sc = np.clip(qc - NA_COLS // 2, 0, GRID_W - NA_COLS)
    kc = starts[:, None] + np.arange(NA_KCOLS)
    valid = (kc[:, None, :] >= sc[..., None]) & (kc[:, None, :] < sc[..., None] + NA_COLS)
    dc = np.clip(kc[:, None, :] - qc[..., None], -(NA_COLS - 1), NA_COLS - 1)
    return kc, valid, dc


def neighborhood_attention(zd, rpb):
    bsz, seq = zd.shape[:2]
    rows = seq // GRID_W
    kr = min(NA_ROWS_MAX, rows)
    t = zd.reshape(bsz, rows, GRID_W, 3, NA_HEADS, HEAD_DIM)
    q, k, v = t[:, :, :, 0], t[:, :, :, 1], t[:, :, :, 2]
    col_idx, valid, dc = na_col_tables()
    ncb = GRID_W // NA_QCOLS
    bias_c = rpb[:, :, dc + NA_COLS - 1]
    mask = valid[:, :, None, :]
    scale = HEAD_DIM ** -0.5

    def grid_row(r):
        sr = jnp.clip(r - kr // 2, 0, rows - kr)
        kw = lax.dynamic_slice_in_dim(k, sr, kr, axis=1)[:, :, col_idx]
        vw = lax.dynamic_slice_in_dim(v, sr, kr, axis=1)[:, :, col_idx]
        qr = lax.dynamic_index_in_dim(q, r, axis=1, keepdims=False).reshape(bsz, ncb, NA_QCOLS, NA_HEADS, HEAD_DIM)
        s = jnp.einsum('bcqhd,bickhd->bhcqik', qr, kw, preferred_element_type=jnp.float32) * scale
        dr = sr + jnp.arange(kr) - r + NA_ROWS_MAX - 1
        s = s + jnp.moveaxis(bias_c[:, dr], 1, 3).astype(jnp.float32)[None]
        s = jnp.where(mask, s, NEG_INF)
        p = jax.nn.softmax(s, axis=(-2, -1))
        o = jnp.einsum('bhcqik,bickhd->bcqhd', p.astype(vw.dtype), vw)
        return o.reshape(bsz, GRID_W, NA_HEADS * HEAD_DIM)

    o = lax.map(grid_row, jnp.arange(rows))
    return jnp.moveaxis(o, 0, 1).reshape(bsz, seq, NA_HEADS * HEAD_DIM)


def conv_ffn(h, w_up, conv_w, conv_b, w_down):
    u = h @ w_up
    up = jnp.pad(u, ((0, 0), (1, 1), (0, 0)))
    u = up[:, :-2] * conv_w[0] + up[:, 1:-1] * conv_w[1] + up[:, 2:] * conv_w[2] + conv_b
    a, b = jnp.split(u, 2, -1)
    return (jax.nn.gelu(a) * b) @ w_down


def trunk(x, p, ln_attn, w_in, q_norm, kv_norm, w_q_up, w_kv_up, attn_sink, na_rpb, rel_table,
          w_gate, w_branch, w_out, ln_ffn, w_ffn_up, ffn_conv_w, ffn_conv_b, w_ffn_down,
          ln_ple, w_ple_gate, w_ple_proj, ln_final):
    cuts = [A_COLS, A_COLS + B_COLS, A_COLS + B_COLS + C_COLS]
    for i in range(DEPTH):
        h = rmsnorm(x, ln_attn[i])
        za, zb, zc, zd = jnp.split(h @ w_in[i], cuts, axis=-1)
        branches = (
            mla_attention(za, q_norm[i], kv_norm[i], w_q_up[i], w_kv_up[i]),
            dilated_attention(zb, rel_table),
            window_gqa(zc, rel_table, attn_sink[i]),
            neighborhood_attention(zd, na_rpb[i]),
        )
        merged = jnp.zeros_like(x)
        for j, o in enumerate(branches):
            merged = merged + jax.nn.sigmoid(h @ w_gate[i, j]) * (o @ w_branch[i, j])
        x = x + merged @ w_out[i]
        x = x + conv_ffn(rmsnorm(x, ln_ffn[i]), w_ffn_up[i], ffn_conv_w[i], ffn_conv_b[i], w_ffn_down[i])
        x = x + jax.nn.sigmoid(rmsnorm(x, ln_ple[i]) @ w_ple_gate[i]) * (p[i] @ w_ple_proj[i])
    return rmsnorm(x, ln_final)


def setup_inputs(seed: int = 0) -> dict:
    key = jax.random.key(seed)
    ks = iter(jax.random.split(key, 32))

    def nrm(shape, scale):
        return jax.random.normal(next(ks), shape, jnp.float32) * scale

    def gain(shape):
        return 1.0 + nrm(shape, 0.01)

    return {
        'x_prompt': nrm((BATCH, SEQ, D_MODEL), 1.0),
        'x_sample': nrm((DEC_BATCH, DEC_SEQ, D_MODEL), 1.0),
        'p_prompt': nrm((DEPTH, BATCH, SEQ, PLE_DIM), 1.0),
        'p_sample': nrm((DEPTH, DEC_BATCH, DEC_SEQ, PLE_DIM), 1.0),
        'ln_attn': gain((DEPTH, D_MODEL)),
        'w_in': nrm((DEPTH, D_MODEL, IN_COLS), D_MODEL ** -0.5),
        'q_norm': gain((DEPTH, MLA_Q_RANK)),
        'kv_norm': gain((DEPTH, MLA_KV_RANK)),
        'w_q_up': nrm((DEPTH, MLA_Q_RANK, MLA_HEADS * (MLA_NOPE + MLA_ROPE)), MLA_Q_RANK ** -0.5),
        'w_kv_up': nrm((DEPTH, MLA_KV_RANK, MLA_HEADS * (MLA_NOPE + MLA_V)), MLA_KV_RANK ** -0.5),
        'attn_sink': nrm((DEPTH, SWA_Q_HEADS), 1.0),
        'na_rpb': nrm((DEPTH, NA_HEADS, 2 * NA_ROWS_MAX - 1, 2 * NA_COLS - 1), 0.5),
        'rel_table': nrm((REL_BUCKETS, REL_HEADS), 0.5),
        'w_gate': nrm((DEPTH, N_BRANCH, D_MODEL, D_MODEL), D_MODEL ** -0.5),
        'w_branch': nrm((DEPTH, N_BRANCH, BRANCH_W, D_MODEL), BRANCH_W ** -0.5),
        'w_out': nrm((DEPTH, D_MODEL, D_MODEL), D_MODEL ** -0.5),
        'ln_ffn': gain((DEPTH, D_MODEL)),
        'w_ffn_up': nrm((DEPTH, D_MODEL, 2 * D_FF), D_MODEL ** -0.5),
        'ffn_conv_w': nrm((DEPTH, CONV_W, 2 * D_FF), CONV_W ** -0.5),
        'ffn_conv_b': nrm((DEPTH, 2 * D_FF), 0.01),
        'w_ffn_down': nrm((DEPTH, D_FF, D_MODEL), D_FF ** -0.5),
        'ln_ple': gain((DEPTH, D_MODEL)),
        'w_ple_gate': nrm((DEPTH, D_MODEL, D_MODEL), D_MODEL ** -0.5),
        'w_ple_proj': nrm((DEPTH, PLE_DIM, D_MODEL), PLE_DIM ** -0.5),
        'ln_final': gain((D_MODEL,)),
    }


def reference(x_prompt, x_sample, p_prompt, p_sample, ln_attn, w_in, q_norm, kv_norm, w_q_up, w_kv_up,
              attn_sink, na_rpb, rel_table, w_gate, w_branch, w_out, ln_ffn, w_ffn_up, ffn_conv_w,
              ffn_conv_b, w_ffn_down, ln_ple, w_ple_gate, w_ple_proj, ln_final):
    weights = (ln_attn, w_in, q_norm, kv_norm, w_q_up, w_kv_up, attn_sink, na_rpb, rel_table,
               w_gate, w_branch, w_out, ln_ffn, w_ffn_up, ffn_conv_w, ffn_conv_b, w_ffn_down,
               ln_ple, w_ple_gate, w_ple_proj, ln_final)
    y_prompt = trunk(x_prompt, p_prompt, *weights)
    y_sample = trunk(x_sample, p_sample, *weights)
    return (y_prompt, y_sample)
```

```cpp
#include <hip/hip_runtime.h>
#include <hip/hip_cooperative_groups.h>
#include <cstdio>
#include <cstdint>
namespace cg = cooperative_groups;

#define LAS __attribute__((address_space(3)))
typedef unsigned short bf16_t;
typedef short bf16x8 __attribute__((ext_vector_type(8)));
typedef short s16x4 __attribute__((ext_vector_type(4)));
typedef float f32x2 __attribute__((ext_vector_type(2)));
typedef float f32x4 __attribute__((ext_vector_type(4)));
typedef float f32x16 __attribute__((ext_vector_type(16)));
typedef unsigned u32x2 __attribute__((ext_vector_type(2)));
typedef unsigned u32x4 __attribute__((ext_vector_type(4)));
typedef __bf16 bf16x2_t __attribute__((ext_vector_type(2)));

constexpr int DM = 1024, SEQ = 8192, NTOK = 81920, NPROMPT = 65536, TGM = 32768  , NGROUP = 3, DEPTH = 4;
constexpr int ZC = 4096;
constexpr int DFF = 2816, DFF2 = 5632;
constexpr int COL_B = 416, COL_C = 2720, COL_D = 3232;
constexpr float LOG2E = 1.4426950408889634f;
constexpr float EPS = 1e-6f;
constexpr float NEGBIG = -3.0e38f;

constexpr size_t MiB = 1u << 20;
constexpr size_t WS_ROPE = 0;
constexpr size_t WS_TAB = 1 * MiB;
constexpr size_t WS_BAR = 1 * MiB + 512 * 1024, WS_BAR_BYTES = 16384;
constexpr size_t WS_W = 2 * MiB;
constexpr size_t WL_CAT = 0, WL_MLA = 16 * MiB, WL_B = 17 * MiB, WL_OUT = 19 * MiB, WL_UP = 21 * MiB, WL_DOWN = 32 * MiB,
                 WL_PG = 32 * MiB + 5632 * 1024, WL_PP = WL_PG + 2 * MiB, WL_SIZE = 40 * MiB;
constexpr size_t WS_ACT = 162 * MiB;
constexpr size_t WS_Z = WS_ACT, WS_G = WS_ACT, WS_U = WS_ACT, WS_QKV = WS_ACT + 256 * MiB, WS_O = WS_ACT + 320 * MiB, WS_A2 = WS_O, WS_OD = WS_ACT + 384 * MiB,
                 WS_LSE = WS_ACT + 432 * MiB, WS_MB = WS_ACT + 434 * MiB, WS_MG = WS_ACT + 498 * MiB, WS_GA = WS_ACT + 352 * MiB, WS_PP = WS_ACT + 528 * MiB,
                 WS_PB = WS_ACT + 592 * MiB, WS_H = WS_ACT + 608 * MiB, WS_H1 = WS_ACT + 672 * MiB, WS_RS = WS_ACT + 736 * MiB  , WS_RSM = WS_ACT + 742 * MiB  , WS_END = WS_ACT + 743 * MiB;

__device__ __forceinline__ float bf2f(unsigned short b) { return __builtin_bit_cast(float, (unsigned)b << 16); }
__device__ __forceinline__ unsigned cvtpk(float lo, float hi) { f32x2 v = {lo, hi}; bf16x2_t b = __builtin_convertvector(v, bf16x2_t); return __builtin_bit_cast(unsigned, b); }
__device__ __forceinline__ float shx(float v, int o, int lane) { return __builtin_bit_cast(float, __builtin_amdgcn_ds_bpermute((lane ^ o) << 2, __builtin_bit_cast(int, v))); }
__device__ __forceinline__ void xhalf_swap(float& a, float& b) { asm volatile("s_nop 1\n\tv_permlane32_swap_b32 %0, %1\n\ts_nop 1" : "+v"(a), "+v"(b)); }
__device__ __forceinline__ float xhalf_max(float v) { float a = v, b = v; xhalf_swap(a, b); return fmaxf(a, b); }
__device__ __forceinline__ float xhalf_sum(float v) { float a = v, b = v; xhalf_swap(a, b); return a + b; }
__device__ __forceinline__ float wave_sum(float v, int lane) {
#pragma unroll
    for (int o = 1; o < 64; o <<= 1) v += shx(v, o, lane);
    return v;
}
__device__ __forceinline__ float sigmoidf_(float v) { return __builtin_amdgcn_rcpf(1.0f + __expf(-v)); }
__device__ __forceinline__ float gelu_tanh(float x) { const float u = 0.7978845608028654f * (x + 0.044715f * x * x * x); return x * sigmoidf_(2.0f * u); }
__device__ __forceinline__ void st16_wt(void* p, u32x4 v) { asm volatile("global_store_dwordx4 %0, %1, off sc1\n\ts_nop 2" :: "v"(p), "v"(v) : "memory"); }
__device__ __forceinline__ void st16f_wt(void* p, f32x4 v) { asm volatile("global_store_dwordx4 %0, %1, off sc1\n\ts_nop 2" :: "v"(p), "v"(v) : "memory"); }
__device__ __forceinline__ int crow(int r, int hi) { return (r & 3) + 8 * (r >> 2) + 4 * hi; }
__device__ __forceinline__ int ltid(int wv) { unsigned z = 0u; asm volatile("" : "+v"(z)); return wv * 64 + (int)__builtin_amdgcn_mbcnt_hi(~0u, __builtin_amdgcn_mbcnt_lo(~0u, z)); }
__device__ __forceinline__ int lgrid() { int g = gridDim.x; asm volatile("" : "+s"(g)); return g; }
__device__ __forceinline__ int lbid() { int b = blockIdx.x; asm volatile("" : "+s"(b)); return b; }
__device__ __forceinline__ int clampi(int v, int lo, int hi) { return v < lo ? lo : (v > hi ? hi : v); }

namespace pg8 {
constexpr int BM = 256, BK = 64, HALF = 128, HTB = HALF * BK * 2, STAGE_BYTES = 8 * HTB, NXCD = 8, WGM = 8;
__host__ __device__ __forceinline__ int lds_byte(int r, int c) { const int st = (r >> 4) * 2 + (c >> 5), rr = r & 15, cc = c & 31, ob = rr * 64 + cc * 2; return st * 1024 + (ob ^ (((ob >> 9) & 1) << 5)); }
__host__ __device__ __forceinline__ void stage_rc(int b, int& R, int& C) { const int st = b / 1024, sb = b % 1024, swz = sb ^ (((sb >> 9) & 1) << 5); R = (st >> 1) * 16 + swz / 64; C = (st & 1) * 32 + (swz % 64) / 2; }
__host__ __device__ __forceinline__ int perm32(int rho) { const int n = rho >> 4, i = rho & 15; return 8 * (i >> 2) + 4 * n + (i & 3); }

struct Unit { int pm, pn, ak; };
struct Gemm { const bf16_t* A; const bf16_t* Bt; int lda, ldb, K; };

struct StaticOrder {
    int nM, nN, nwg, G, c;
    __device__ __forceinline__ void init(int M, int N, int G_, int c_) { nM = M / BM; nN = N / BM; nwg = nM * nN; G = G_; c = c_; }
    __device__ __forceinline__ bool next(int i, Unit& u) const {
        const long L = (long)i * G + c; if (L >= nwg) return false;
        int wgid = (int)L; { const int q = nwg / NXCD, r = nwg % NXCD, xcd = wgid % NXCD, off = wgid / NXCD; wgid = (xcd < r ? xcd * (q + 1) : r * (q + 1) + (xcd - r) * q) + off; }
        const int nig = WGM * nN, gid = wgid / nig, fm = gid * WGM, gsz = (nM - fm) < WGM ? (nM - fm) : WGM;
        u.pm = fm + ((wgid % nig) % gsz); u.pn = (wgid % nig) / gsz; u.ak = 0; return true;
    }
};
struct BranchOrder {
    int G, c, ntile;
    __device__ __forceinline__ bool next(int i, Unit& u) const {
        const int L = (i >> 2) * G + c; if (L >= ntile) return false;
        const int j = i & 3; u.pm = L >> 2; u.pn = j * 4 + (L & 3); u.ak = j * 256; return true;
    }
};

#define EPI_LOOP_ROWS for (int ai = 0; ai < 2; ++ai) _Pragma("unroll") for (int m = 0; m < 4; ++m)

__device__ __forceinline__ float row_part(const float* RS, int row, int fq) { const f32x4 a = ((const f32x4*)(RS + (size_t)row * 16))[fq]; return (a.x + a.y) + (a.z + a.w); }
__device__ __forceinline__ float row_rstd_fin(float s, int lane) { s += shx(s, 16, lane); s += shx(s, 32, lane); return rsqrtf(s * (1.0f / 1024.0f) + EPS); }
struct EpiBf16 {
    static constexpr bool PERM = true;
    bf16_t* O0; bf16_t* O1; int ldc; int split_pn; const float* RS; float* RSM;
    __device__ __forceinline__ void operator()(const f32x4 (&acc)[2][2][4][2], const Unit& u, int wv) const {
        const int t_ = ltid(wv), wid_ = __builtin_amdgcn_readfirstlane(t_ >> 6), wr = wid_ >> 2, wc = wid_ & 3, fr = t_ & 15, fq = (t_ & 63) >> 4;
        const bool gate = u.pn >= split_pn;
        bf16_t* base = gate ? O1 : O0;
        const int col0 = (gate ? (u.pn - split_pn) : u.pn) * BM + wc * 32 + 8 * fq;
        const int row0 = u.pm * BM + wr * 64 + fr;
        float rs[2][4];
#pragma unroll
        EPI_LOOP_ROWS rs[ai][m] = RS ? row_part(RS, row0 + ai * HALF + m * 16, fq) : 0.f;
#pragma unroll
        EPI_LOOP_ROWS rs[ai][m] = RS ? row_rstd_fin(rs[ai][m], t_ & 63) : 1.0f;
#pragma unroll
        EPI_LOOP_ROWS { bf16_t* rowp = base + (size_t)(row0 + ai * HALF + m * 16) * ldc + col0;
            const float rstd = rs[ai][m];
            float ssm = 0.f;
#pragma unroll
            for (int bj = 0; bj < 2; ++bj) { f32x4 v0 = acc[ai][bj][m][0] * rstd, v1 = acc[ai][bj][m][1] * rstd;
                if (RSM && (u.pn == 0 || (u.pn == 1 && bj == 0))) ssm += ((v0[0] * v0[0] + v0[1] * v0[1]) + (v0[2] * v0[2] + v0[3] * v0[3])) + ((v1[0] * v1[0] + v1[1] * v1[1]) + (v1[2] * v1[2] + v1[3] * v1[3]));
                if (gate) {
#pragma unroll
                    for (int e = 0; e < 4; ++e) { v0[e] = sigmoidf_(v0[e]); v1[e] = sigmoidf_(v1[e]); } }
                u32x4 w; w.x = cvtpk(v0[0], v0[1]); w.y = cvtpk(v0[2], v0[3]); w.z = cvtpk(v1[0], v1[1]); w.w = cvtpk(v1[2], v1[3]);
                st16_wt(rowp + bj * HALF, w); }
            if (RSM && u.pn < 2) { ssm += shx(ssm, 16, t_ & 63); ssm += shx(ssm, 32, t_ & 63);
                if (fq == 0) RSM[(size_t)(row0 + ai * HALF + m * 16) * 8 + u.pn * 4 + wc] = ssm; } }
    }
};
struct EpiMla {
    static constexpr bool PERM = false;
    bf16_t* O; const float* rcos; const float* rsin; float qscale; const float* RSM;
    __device__ __forceinline__ void operator()(const f32x4 (&acc)[2][2][4][2], const Unit& u, int wv) const {
        const int t_ = ltid(wv), wid_ = __builtin_amdgcn_readfirstlane(t_ >> 6), wr = wid_ >> 2, wc = wid_ & 3, fr = t_ & 15, fq = (t_ & 63) >> 4;
        const int row0 = u.pm * BM + wr * 64 + fr;
        float rq[2][4], rkv[2][4];
#pragma unroll
        EPI_LOOP_ROWS { const f32x4* p_ = (const f32x4*)(RSM + (size_t)(row0 + ai * HALF + m * 16) * 8); const f32x4 a_ = p_[0], b_ = p_[1];
            rq[ai][m] = rsqrtf(((a_.x + a_.y) + (a_.z + a_.w)) * (1.0f / 256.0f) + EPS); rkv[ai][m] = rsqrtf(((b_.x + b_.y) + (b_.z + b_.w)) * (1.0f / 128.0f) + EPS); }
#pragma unroll
        for (int bj = 0; bj < 2; ++bj) {
            const int cg = u.pn * BM + bj * HALF + wc * 32;
            const bool rope = (cg < 768) && ((cg % 96) == 64);
            const int kind = (cg < 384) ? 0 : ((cg < 768 && rope) ? 2 : 1);
#pragma unroll
            EPI_LOOP_ROWS { const int row = row0 + ai * HALF + m * 16; f32x4 v0 = acc[ai][bj][m][0], v1 = acc[ai][bj][m][1];
                const float sc = kind == 0 ? qscale * rq[ai][m] : (kind == 1 ? rkv[ai][m] : 1.0f);
                if (rope) { const int pos = row & (SEQ - 1); const f32x4 c = *(const f32x4*)(rcos + pos * 16 + 4 * fq), s = *(const f32x4*)(rsin + pos * 16 + 4 * fq);
                    const f32x4 a = v0 * c - v1 * s, b = v0 * s + v1 * c; v0 = a; v1 = b; }
                v0 = v0 * sc; v1 = v1 * sc;
                bf16_t* p = O + (size_t)row * 1024 + cg + 4 * fq;
                u32x2 w0, w1; w0.x = cvtpk(v0[0], v0[1]); w0.y = cvtpk(v0[2], v0[3]); w1.x = cvtpk(v1[0], v1[1]); w1.y = cvtpk(v1[2], v1[3]);
                *(u32x2*)p = w0; *(u32x2*)(p + 16) = w1; } }
    }
};
struct EpiBranch {
    static constexpr bool PERM = true;
    const bf16_t* Gt; bf16_t* MB; bf16_t* MG;
    __device__ __forceinline__ void operator()(const f32x4 (&acc)[2][2][4][2], const Unit& u, int wv) const {
        const int t_ = ltid(wv), wid_ = __builtin_amdgcn_readfirstlane(t_ >> 6), wr = wid_ >> 2, wc = wid_ & 3, fr = t_ & 15, fq = (t_ & 63) >> 4;
        const int j = u.pn >> 2, tn = u.pn & 3;
        const int col0 = tn * BM + wc * 32 + 8 * fq, row0 = u.pm * BM + wr * 64 + fr;
#pragma unroll
        EPI_LOOP_ROWS { const int row = row0 + ai * HALF + m * 16;
#pragma unroll
            for (int bj = 0; bj < 2; ++bj) { const int col = col0 + bj * HALF;
                const u32x4 g = *(const u32x4*)(Gt + (unsigned)(row * ZC + j * 1024 + col));
                f32x4 v0 = acc[ai][bj][m][0], v1 = acc[ai][bj][m][1];
                v0[0] *= __builtin_bit_cast(float, g.x << 16); v0[1] *= __builtin_bit_cast(float, g.x & 0xffff0000u);
                v0[2] *= __builtin_bit_cast(float, g.y << 16); v0[3] *= __builtin_bit_cast(float, g.y & 0xffff0000u);
                v1[0] *= __builtin_bit_cast(float, g.z << 16); v1[1] *= __builtin_bit_cast(float, g.z & 0xffff0000u);
                v1[2] *= __builtin_bit_cast(float, g.w << 16); v1[3] *= __builtin_bit_cast(float, g.w & 0xffff0000u);
                bf16_t* mp = MB + (unsigned)(row * 1024 + col);
                if (j > 0) { const u32x4 pm_ = *(const u32x4*)mp;
                    v0[0] += __builtin_bit_cast(float, pm_.x << 16); v0[1] += __builtin_bit_cast(float, pm_.x & 0xffff0000u);
                    v0[2] += __builtin_bit_cast(float, pm_.y << 16); v0[3] += __builtin_bit_cast(float, pm_.y & 0xffff0000u);
                    v1[0] += __builtin_bit_cast(float, pm_.z << 16); v1[1] += __builtin_bit_cast(float, pm_.z & 0xffff0000u);
                    v1[2] += __builtin_bit_cast(float, pm_.w << 16); v1[3] += __builtin_bit_cast(float, pm_.w & 0xffff0000u); }
                if (j < 3) { u32x4 w; w.x = cvtpk(v0[0], v0[1]); w.y = cvtpk(v0[2], v0[3]); w.z = cvtpk(v1[0], v1[1]); w.w = cvtpk(v1[2], v1[3]); *(u32x4*)mp = w; }
                else { u32x4 w; w.x = cvtpk(v0[0], v0[1]); w.y = cvtpk(v0[2], v0[3]); w.z = cvtpk(v1[0], v1[1]); w.w = cvtpk(v1[2], v1[3]); *(u32x4*)(MG + (unsigned)(row * 1024 + col)) = w; } }
            if (m & 1) asm volatile("" ::: "memory"); }
    }
};
struct EpiResid {
    static constexpr bool PERM = true;
    float* X; const bf16_t* PP; const float* RSin; bf16_t* XB; float* RSout;
    __device__ __forceinline__ void operator()(const f32x4 (&acc)[2][2][4][2], const Unit& u, int wv) const {
        const int t_ = ltid(wv), wid_ = __builtin_amdgcn_readfirstlane(t_ >> 6), wr = wid_ >> 2, wc = wid_ & 3, fr = t_ & 15, fq = (t_ & 63) >> 4;
        const int col0 = u.pn * BM + wc * 32 + 8 * fq, row0 = u.pm * BM + wr * 64 + fr;
        float rs[2][4], sq[2][4];
#pragma unroll
        EPI_LOOP_ROWS rs[ai][m] = RSin ? row_part(RSin, row0 + ai * HALF + m * 16, fq) : 0.f;
#pragma unroll
        EPI_LOOP_ROWS rs[ai][m] = RSin ? row_rstd_fin(rs[ai][m], t_ & 63) : 1.0f;
#pragma unroll
        EPI_LOOP_ROWS { const size_t row = (size_t)(row0 + ai * HALF + m * 16);
            const float rstd = rs[ai][m]; float ssq = 0.f;
#pragma unroll
            for (int bj = 0; bj < 2; ++bj) { const int col = col0 + bj * HALF;
                f32x4 v0 = acc[ai][bj][m][0] * rstd, v1 = acc[ai][bj][m][1] * rstd;
                if (PP) { const u32x4 g = *(const u32x4*)(PP + row * 1024 + col);
                    v0[0] = sigmoidf_(v0[0]) * __builtin_bit_cast(float, g.x << 16); v0[1] = sigmoidf_(v0[1]) * __builtin_bit_cast(float, g.x & 0xffff0000u);
                    v0[2] = sigmoidf_(v0[2]) * __builtin_bit_cast(float, g.y << 16); v0[3] = sigmoidf_(v0[3]) * __builtin_bit_cast(float, g.y & 0xffff0000u);
                    v1[0] = sigmoidf_(v1[0]) * __builtin_bit_cast(float, g.z << 16); v1[1] = sigmoidf_(v1[1]) * __builtin_bit_cast(float, g.z & 0xffff0000u);
                    v1[2] = sigmoidf_(v1[2]) * __builtin_bit_cast(float, g.w << 16); v1[3] = sigmoidf_(v1[3]) * __builtin_bit_cast(float, g.w & 0xffff0000u); }
                float* xp = X + row * 1024 + col;
                v0 += *(const f32x4*)xp; v1 += *(const f32x4*)(xp + 4);
                *(f32x4*)xp = v0; *(f32x4*)(xp + 4) = v1;
                u32x4 w; w.x = cvtpk(v0[0], v0[1]); w.y = cvtpk(v0[2], v0[3]); w.z = cvtpk(v1[0], v1[1]); w.w = cvtpk(v1[2], v1[3]);
                *(u32x4*)(XB + row * 1024 + col) = w;
                ssq += ((v0[0] * v0[0] + v0[1] * v0[1]) + (v0[2] * v0[2] + v0[3] * v0[3])) + ((v1[0] * v1[0] + v1[1] * v1[1]) + (v1[2] * v1[2] + v1[3] * v1[3])); }
            sq[ai][m] = ssq;
            if (m & 1) asm volatile("" ::: "memory"); }
#pragma unroll
        EPI_LOOP_ROWS sq[ai][m] += shx(sq[ai][m], 16, t_ & 63);
#pragma unroll
        EPI_LOOP_ROWS sq[ai][m] += shx(sq[ai][m], 32, t_ & 63);
        if (fq == 0) {
#pragma unroll
            EPI_LOOP_ROWS RSout[(size_t)(row0 + ai * HALF + m * 16) * 16 + u.pn * 4 + wc] = sq[ai][m]; }
    }
};

template <class Epi, class Sched>
__device__ __forceinline__ void gemm_phase(LAS unsigned char* lds, const Gemm g, const Sched& S, const Epi& E, int wv) {
    int tid = ltid(wv);
    const int wid = __builtin_amdgcn_readfirstlane(tid >> 6), lane = tid & 63, wr = wid >> 2, wc = wid & 3, fr = lane & 15, fq = lane >> 4;
    const int K = g.K, nt = K / BK;
    unsigned voffA[2], voffB[2];
#pragma unroll
    for (int i = 0; i < 2; ++i) { int R, C; stage_rc(tid * 16 + i * 8192, R, C); const int Rb = Epi::PERM ? ((R & ~31) + perm32(R & 31)) : R;
        voffA[i] = (unsigned)(R * g.lda + C) * 2u; voffB[i] = (unsigned)(Rb * g.ldb + C) * 2u; }
    const size_t kstep = (size_t)(BK * 2);
    const size_t hstepA = (size_t)HALF * g.lda * 2, hstepB = (size_t)HALF * g.ldb * 2;
    const size_t tstepA = 2 * hstepA, tstepB = 2 * hstepB;
    const unsigned ldsw = (unsigned)wid * 1024u;
    const int aoff = lds_byte(wr * 64 + fr, fq * 8), boff = lds_byte(wc * 32 + fr, fq * 8);
#define PG8_SA(b, h) (((b) * 2 + (h)) * HTB)
#define PG8_SB(b, h) ((4 + (b) * 2 + (h)) * HTB)
#define PG8_STAGE(bufoff, gbase, voff) do { _Pragma("unroll") for (int _i = 0; _i < 2; ++_i) \
        __builtin_amdgcn_global_load_lds((const unsigned*)((const char*)(gbase) + (voff)[_i]), (LAS unsigned*)(lds + (bufoff) + ldsw + _i * 8192), 16, 0, 0); } while (0)
#define PG8_LDA(dst, b, h) do { _Pragma("unroll") for (int m = 0; m < 4; ++m) _Pragma("unroll") for (int k = 0; k < 2; ++k) dst[m][k] = *(const LAS bf16x8*)(lds + PG8_SA(b, h) + aoff + m * 2048 + k * 1024); } while (0)
#define PG8_LDB(dst, b, h) do { _Pragma("unroll") for (int n = 0; n < 2; ++n) _Pragma("unroll") for (int k = 0; k < 2; ++k) dst[n][k] = *(const LAS bf16x8*)(lds + PG8_SB(b, h) + boff + n * 2048 + k * 1024); } while (0)
#define PG8_MMA(ai, bj, At, Bt) do { __builtin_amdgcn_s_setprio(1); _Pragma("unroll") for (int m = 0; m < 4; ++m) _Pragma("unroll") for (int n = 0; n < 2; ++n) _Pragma("unroll") for (int k = 0; k < 2; ++k) \
        acc[ai][bj][m][n] = __builtin_amdgcn_mfma_f32_16x16x32_bf16(Bt[n][k], At[m][k], acc[ai][bj][m][n], 0, 0, 0); __builtin_amdgcn_s_setprio(0); } while (0)
#define PG8_WAIT_V(n) asm volatile("s_waitcnt vmcnt(" #n ")" ::: "memory")
#define PG8_WAIT_L(n) asm volatile("s_waitcnt lgkmcnt(" #n ")" ::: "memory")
#define PG8_BAR __builtin_amdgcn_s_barrier()
#define PG8_SCHED __builtin_amdgcn_sched_barrier(0)
    Unit cur, nxt; int ui = 0;
    if (!S.next(0, cur)) return;
    f32x4 acc[2][2][4][2];
#pragma unroll
    for (int a = 0; a < 2; ++a)
#pragma unroll
        for (int b = 0; b < 2; ++b)
#pragma unroll
            for (int m = 0; m < 4; ++m)
#pragma unroll
                for (int n = 0; n < 2; ++n) acc[a][b][m][n] = (f32x4){0.f, 0.f, 0.f, 0.f};
    bf16x8 At[4][2], B0[2][2], B1[2][2];
    const char* cA = (const char*)g.A + (size_t)cur.pm * tstepA + (size_t)cur.ak * 2; const char* cB = (const char*)g.Bt + (size_t)cur.pn * tstepB;
    PG8_STAGE(PG8_SB(0, 0), cB, voffB); PG8_STAGE(PG8_SB(0, 1), cB + hstepB, voffB); PG8_STAGE(PG8_SA(0, 0), cA, voffA); PG8_STAGE(PG8_SA(0, 1), cA + hstepA, voffA);
    if (wr == 1) PG8_BAR;
    PG8_WAIT_V(2); PG8_BAR;
    PG8_STAGE(PG8_SB(1, 0), cB + kstep, voffB); PG8_STAGE(PG8_SA(1, 0), cA + kstep, voffA); PG8_STAGE(PG8_SB(1, 1), cB + hstepB + kstep, voffB);
    PG8_WAIT_V(6); PG8_BAR;
    for (;;) {
        const bool has_next = S.next(ui + 1, nxt);
        const char* nA = has_next ? (const char*)g.A + (size_t)nxt.pm * tstepA + (size_t)nxt.ak * 2 : cA; const char* nB = has_next ? (const char*)g.Bt + (size_t)nxt.pn * tstepB : cB;
        for (int t = 0; t < nt; t += 2) {
            const bool last = (t == nt - 2);
            const char* a1 = cA + (size_t)(t + 1) * kstep;
            const char* a2 = last ? nA : cA + (size_t)(t + 2) * kstep; const char* b2 = last ? nB : cB + (size_t)(t + 2) * kstep;
            const char* a3 = a2 + kstep; const char* b3 = b2 + kstep;
            PG8_LDB(B0, 0, 0); PG8_LDB(B1, 0, 1); PG8_SCHED; PG8_LDA(At, 0, 0); PG8_STAGE(PG8_SA(1, 1), a1 + hstepA, voffA);
            PG8_WAIT_V(8); PG8_WAIT_L(0); PG8_BAR; PG8_MMA(0, 0, At, B0); PG8_MMA(0, 1, At, B1); PG8_BAR; PG8_SCHED;
            PG8_LDA(At, 0, 1); PG8_STAGE(PG8_SB(0, 0), b2, voffB); PG8_STAGE(PG8_SB(0, 1), b2 + hstepB, voffB); PG8_STAGE(PG8_SA(0, 0), a2, voffA);
            PG8_WAIT_V(8); PG8_WAIT_L(0); PG8_BAR; PG8_MMA(1, 0, At, B0); PG8_MMA(1, 1, At, B1); PG8_BAR; PG8_SCHED;
            PG8_LDB(B0, 1, 0); PG8_LDB(B1, 1, 1); PG8_SCHED; PG8_LDA(At, 1, 0); PG8_STAGE(PG8_SA(0, 1), a2 + hstepA, voffA);
            PG8_WAIT_V(8); PG8_WAIT_L(0); PG8_BAR; PG8_MMA(0, 0, At, B0); PG8_MMA(0, 1, At, B1); PG8_BAR; PG8_SCHED;
            PG8_LDA(At, 1, 1); PG8_STAGE(PG8_SB(1, 0), b3, voffB); PG8_STAGE(PG8_SB(1, 1), b3 + hstepB, voffB); PG8_STAGE(PG8_SA(1, 0), a3, voffA);
            PG8_WAIT_V(8); PG8_WAIT_L(0); PG8_BAR; PG8_MMA(1, 0, At, B0); PG8_MMA(1, 1, At, B1); PG8_BAR; PG8_SCHED;
        }
        if (wr == 0) PG8_BAR;
        E(acc, cur, wv);
        if (!has_next) break;
#pragma unroll
        for (int a = 0; a < 2; ++a)
#pragma unroll
            for (int b = 0; b < 2; ++b)
#pragma unroll
                for (int m = 0; m < 4; ++m)
#pragma unroll
                    for (int n = 0; n < 2; ++n) acc[a][b][m][n] = (f32x4){0.f, 0.f, 0.f, 0.f};
        cur = nxt; cA = nA; cB = nB; ++ui;
        if (wr == 1) PG8_BAR;
    }
    PG8_WAIT_V(0);
    PG8_BAR;
#undef PG8_SA
#undef PG8_SB
#undef PG8_STAGE
#undef PG8_LDA
#undef PG8_LDB
#undef PG8_MMA
#undef PG8_WAIT_V
#undef PG8_WAIT_L
#undef PG8_BAR
#undef PG8_SCHED
}
}

struct Args { const float* in[25]; float* out; unsigned char* ws; int lo, hi; };
typedef const __attribute__((address_space(4))) Args* ArgP;
enum { I_XP = 0, I_XS, I_PP, I_PS, I_LNA, I_WIN, I_QN, I_KVN, I_WQUP, I_WKVUP, I_SINK, I_RPB, I_REL, I_WGATE, I_WBR, I_WOUT, I_LNF, I_WUP, I_CW, I_CB, I_WDOWN, I_LNP, I_WPG, I_WPP, I_LNFIN };

__device__ __forceinline__ void transpose_item(const float* W, const float* gain, int N, bf16_t* WT, int ldo, int row_off, LAS float* scr, int item, int lane) {
    const int nblk = N / 32, kb = item / nblk, nb = item % nblk, k0 = 64 * kb, n0 = 32 * nb;
#pragma unroll 8
    for (int i = 0; i < 32; ++i) { const int kk = 2 * i + (lane >> 5); scr[kk * 33 + (lane & 31)] = W[(size_t)(k0 + kk) * N + n0 + (lane & 31)]; }
    asm volatile("s_waitcnt lgkmcnt(0)" ::: "memory");
    const int c = lane & 7;
    f32x4 g0 = {1.f, 1.f, 1.f, 1.f}, g1 = g0;
    if (gain) { g0 = *(const f32x4*)(gain + k0 + 8 * c); g1 = *(const f32x4*)(gain + k0 + 8 * c + 4); }
#pragma unroll
    for (int j = 0; j < 4; ++j) { const int n = (lane >> 3) + 8 * j; const LAS float* s = scr + (8 * c) * 33 + n;
        u32x4 o; o.x = cvtpk(s[0 * 33] * g0.x, s[1 * 33] * g0.y); o.y = cvtpk(s[2 * 33] * g0.z, s[3 * 33] * g0.w); o.z = cvtpk(s[4 * 33] * g1.x, s[5 * 33] * g1.y); o.w = cvtpk(s[6 * 33] * g1.z, s[7 * 33] * g1.w);
        *(u32x4*)(WT + (size_t)(row_off + n0 + n) * ldo + k0 + 8 * c) = o; }
    asm volatile("s_waitcnt lgkmcnt(0)" ::: "memory");
}
__device__ __forceinline__ void cvt_matrix(const float* W, const float* gain, int K, int N, bf16_t* WT, int ldo, int row_off, LAS float* scr, int gw, int NGW, int lane, int& base) {
    const int nitems = (K / 64) * (N / 32);
    for (int it = (gw - base % NGW + NGW) % NGW; it < nitems; it += NGW) transpose_item(W, gain, N, WT, ldo, row_off, scr, it, lane);
    base += nitems;
}
__device__ __forceinline__ int t5_bucket(int rel) {
    const int ret = rel > 0 ? 16 : 0; const int n = rel < 0 ? -rel : rel;
    const float nf = (float)(n > 1 ? n : 1);
    int large = 8 + (int)(logf(nf / 8.0f) / 4.852030263919617f * 8.0f);
    large = large < 15 ? large : 15;
    return ret + (n < 8 ? n : large);
}
__device__ __forceinline__ void prologue(ArgP ap, LAS unsigned char* lds, int wv) {
    const int tid = ltid(wv), lane = tid & 63, wave = tid >> 6, G = lgrid(), bid = lbid();
    const int gw = bid * 8 + wave, NGW = G * 8;
    const int gt = bid * 512 + tid, NGT = G * 512;
    LAS float* scr = (LAS float*)(lds + wave * 16384);
    unsigned char* ws = ap->ws;
    int cbase = 0;
    for (int L = 0; L < DEPTH; ++L) {
        unsigned char* wl = ws + WS_W + (size_t)L * WL_SIZE;
        bf16_t* cat = (bf16_t*)(wl + WL_CAT);
        cvt_matrix(ap->in[I_WIN] + (size_t)L * 1024 * 4000, ap->in[I_LNA] + L * DM, 1024, 4000, cat, 1024, 0, scr, gw, NGW, lane, cbase);
        for (int i = gt; i < 96 * 1024 / 8; i += NGT) ((u32x4*)(cat + 4000 * 1024))[i] = (u32x4){0u, 0u, 0u, 0u};
        for (int j = 0; j < 4; ++j) cvt_matrix(ap->in[I_WGATE] + ((size_t)L * 4 + j) * 1024 * 1024, ap->in[I_LNA] + L * DM, 1024, 1024, cat, 1024, 4096 + j * 1024, scr, gw, NGW, lane, cbase);
        for (int j = 0; j < 4; ++j) cvt_matrix(ap->in[I_WBR] + ((size_t)L * 4 + j) * 256 * 1024, nullptr, 256, 1024, (bf16_t*)(wl + WL_B), 256, j * 1024, scr, gw, NGW, lane, cbase);
        cvt_matrix(ap->in[I_WOUT] + (size_t)L * 1024 * 1024, nullptr, 1024, 1024, (bf16_t*)(wl + WL_OUT), 1024, 0, scr, gw, NGW, lane, cbase);
        cvt_matrix(ap->in[I_WUP] + (size_t)L * 1024 * DFF2, ap->in[I_LNF] + L * DM, 1024, DFF2, (bf16_t*)(wl + WL_UP), 1024, 0, scr, gw, NGW, lane, cbase);
        cvt_matrix(ap->in[I_WDOWN] + (size_t)L * DFF * 1024, nullptr, DFF, 1024, (bf16_t*)(wl + WL_DOWN), DFF, 0, scr, gw, NGW, lane, cbase);
        cvt_matrix(ap->in[I_WPG] + (size_t)L * 1024 * 1024, ap->in[I_LNP] + L * DM, 1024, 1024, (bf16_t*)(wl + WL_PG), 1024, 0, scr, gw, NGW, lane, cbase);
        cvt_matrix(ap->in[I_WPP] + (size_t)L * 256 * 1024, nullptr, 256, 1024, (bf16_t*)(wl + WL_PP), 256, 0, scr, gw, NGW, lane, cbase);
        bf16_t* wm = (bf16_t*)(wl + WL_MLA);
        const float* wq = ap->in[I_WQUP] + (size_t)L * 256 * 384; const float* wkv = ap->in[I_WKVUP] + (size_t)L * 128 * 512;
        const float* gqn = ap->in[I_QN] + L * 256; const float* gkvn = ap->in[I_KVN] + L * 128;
        for (int i = gt; i < 1024 * 512; i += NGT) {
            const int n = i >> 9, k = i & 511; float v = 0.f;
            if (n < 384) { if (k < 256) v = wq[k * 384 + n] * gqn[k]; }
            else if (n < 768) { const int n2 = n - 384, h = n2 / 96, d = n2 % 96;
                if (d < 64) { if (k >= 256 && k < 384) v = wkv[(k - 256) * 512 + h * 128 + d] * gkvn[k - 256]; }
                else { if (k == 384 + (d - 64)) v = 1.0f; } }
            else { const int n2 = n - 768, h = n2 >> 6, d = n2 & 63; if (k >= 256 && k < 384) v = wkv[(k - 256) * 512 + h * 128 + 64 + d] * gkvn[k - 256]; }
            wm[i] = (bf16_t)(cvtpk(v, 0.f) & 0xffffu);
        }
    }
    float* rc = (float*)(ws + WS_ROPE); float* rs = rc + SEQ * 16;
    for (int i = gt; i < SEQ * 16; i += NGT) {
        const int pos = i >> 4, f = i & 15;
        const float inv = powf(10000.0f, -(float)(2 * f) / 32.0f);
        const float ang = (float)pos * inv;
        const double rev = (double)ang * 0.15915494309189535; const double fr = rev - floor(rev);
        rc[i] = __builtin_amdgcn_cosf((float)fr); rs[i] = __builtin_amdgcn_sinf((float)fr);
    }
    float* tswa = (float*)(ws + WS_TAB); float* tdil = tswa + 4 * 257;
    const float* rel = ap->in[I_REL];
    for (int i = gt; i < 4 * 257; i += NGT) { const int h = i / 257, off = i % 257 - 128; tswa[i] = rel[t5_bucket(off) * 16 + 12 + h] * LOG2E; }
    for (int i = gt; i < 12 * 129; i += NGT) { const int hh = i / 129, d = i % 129 - 64, gi = hh >> 2; const int dil = gi == 0 ? 1 : (gi == 1 ? 4 : 16);
        tdil[i] = rel[t5_bucket(d * dil) * 16 + hh] * LOG2E; }
}

__device__ __forceinline__ void intake_rows(const float* src, float* copy_dst, bf16_t* dst, float* RS, int nrows, int wv) {
    const int tid_ = ltid(wv); const int lane = tid_ & 63, gw = lbid() * 8 + (tid_ >> 6), NGW = lgrid() * 8;
    for (int m = gw; m < nrows; m += NGW) {
        const f32x4* xr = (const f32x4*)(src + (size_t)m * DM) + lane;
        f32x4 v[4]; float s = 0.f;
#pragma unroll
        for (int j = 0; j < 4; ++j) { v[j] = xr[64 * j]; s += (v[j].x * v[j].x + v[j].y * v[j].y) + (v[j].z * v[j].z + v[j].w * v[j].w); }
        s = wave_sum(s, lane);
        f32x4* cr = (f32x4*)(copy_dst + (size_t)m * DM) + lane;
#pragma unroll
        for (int j = 0; j < 4; ++j) cr[64 * j] = v[j];
        u32x2* o8 = (u32x2*)(dst + (size_t)m * DM) + lane;
#pragma unroll
        for (int j = 0; j < 4; ++j) { u32x2 w; w.x = cvtpk(v[j].x, v[j].y); w.y = cvtpk(v[j].z, v[j].w); o8[64 * j] = w; }
        if (lane < 16) RS[(size_t)m * 16 + lane] = lane == 0 ? s : 0.f;
    }
}
__device__ __forceinline__ void norm_rows(const float* src, float* copy_dst, const float* gain, bf16_t* dst, int nrows, int wv) {
    const int tid_ = ltid(wv); const int lane = tid_ & 63, gw = lbid() * 8 + (tid_ >> 6), NGW = lgrid() * 8;
    f32x4 gn[4];
#pragma unroll
    for (int j = 0; j < 4; ++j) gn[j] = ((const f32x4*)gain)[lane + 64 * j];
    for (int m = gw; m < nrows; m += NGW) {
        const f32x4* xr = (const f32x4*)(src + (size_t)m * DM) + lane;
        f32x4 v[4]; float s = 0.f;
#pragma unroll
        for (int j = 0; j < 4; ++j) { v[j] = xr[64 * j]; s += (v[j].x * v[j].x + v[j].y * v[j].y) + (v[j].z * v[j].z + v[j].w * v[j].w); }
        const float rstd = rsqrtf(wave_sum(s, lane) * (1.f / DM) + EPS);
        if (copy_dst) { f32x4* cr = (f32x4*)(copy_dst + (size_t)m * DM) + lane;
#pragma unroll
            for (int j = 0; j < 4; ++j) cr[64 * j] = v[j]; }
        u32x2* o8 = (u32x2*)(dst + (size_t)m * DM) + lane;
#pragma unroll
        for (int j = 0; j < 4; ++j) { const f32x4 y = v[j] * rstd * gn[j]; u32x2 w; w.x = cvtpk(y.x, y.y); w.y = cvtpk(y.z, y.w); o8[64 * j] = w; }
    }
}
__device__ __forceinline__ void final_norm_rows(float* x, const float* gain, int nrows, int wv) {
    const int tid_ = ltid(wv); const int lane = tid_ & 63, gw = lbid() * 8 + (tid_ >> 6), NGW = lgrid() * 8;
    f32x4 gn[4];
#pragma unroll
    for (int j = 0; j < 4; ++j) gn[j] = ((const f32x4*)gain)[lane + 64 * j];
    for (int m = gw; m < nrows; m += NGW) {
        f32x4* xr = (f32x4*)(x + (size_t)m * DM) + lane;
        f32x4 v[4]; float s = 0.f;
#pragma unroll
        for (int j = 0; j < 4; ++j) { v[j] = xr[64 * j]; s += (v[j].x * v[j].x + v[j].y * v[j].y) + (v[j].z * v[j].z + v[j].w * v[j].w); }
        const float rstd = rsqrtf(wave_sum(s, lane) * (1.f / DM) + EPS);
#pragma unroll
        for (int j = 0; j < 4; ++j) xr[64 * j] = v[j] * rstd * gn[j];
    }
}
__device__ __forceinline__ void mla_prep(const bf16_t* __restrict__ Z, const float* __restrict__ qn, const float* __restrict__ kvn, bf16_t* __restrict__ A2, int r0, int wv) {
    const int tid_ = ltid(wv); const int lane = tid_ & 63;
    const f32x4 gq = ((const f32x4*)qn)[lane]; const f32x2 gk = ((const f32x2*)kvn)[lane];
#pragma unroll 8
    for (int t = r0 + wv * 32; t < r0 + wv * 32 + 32; ++t) {
        const bf16_t* z = Z + (size_t)t * ZC;
        const u32x2 a = *(const u32x2*)(z + 4 * lane);
        const unsigned b = *(const unsigned*)(z + 256 + 2 * lane);
        const unsigned short c = lane < 32 ? z[384 + lane] : (unsigned short)0;
        const float a0 = __builtin_bit_cast(float, a.x << 16), a1 = __builtin_bit_cast(float, a.x & 0xffff0000u), a2 = __builtin_bit_cast(float, a.y << 16), a3 = __builtin_bit_cast(float, a.y & 0xffff0000u);
        const float b0 = __builtin_bit_cast(float, b << 16), b1 = __builtin_bit_cast(float, b & 0xffff0000u);
        const float rq = rsqrtf(wave_sum(a0 * a0 + a1 * a1 + a2 * a2 + a3 * a3, lane) * (1.f / 256.f) + EPS);
        const float rk = rsqrtf(wave_sum(b0 * b0 + b1 * b1, lane) * (1.f / 128.f) + EPS);
        bf16_t* o = A2 + (size_t)t * 512;
        u32x2 w; w.x = cvtpk(a0 * rq * gq.x, a1 * rq * gq.y); w.y = cvtpk(a2 * rq * gq.z, a3 * rq * gq.w);
        *(u32x2*)(o + 4 * lane) = w;
        *(unsigned*)(o + 256 + 2 * lane) = cvtpk(b0 * rk * gk.x, b1 * rk * gk.y);
        o[384 + lane] = c;
        o[448 + lane] = 0;
    }
}
__device__ __forceinline__ float bfe(const u32x4& w, int e) { return (e & 1) ? __builtin_bit_cast(float, w[e >> 1] & 0xffff0000u) : __builtin_bit_cast(float, w[e >> 1] << 16); }
__device__ __forceinline__ void conv_pass(const bf16_t* __restrict__ U, const float* __restrict__ cw, const float* __restrict__ cb, bf16_t* __restrict__ GA, int tg, int wv) {
    const int gt = lbid() * 512 + ltid(wv), NGT = lgrid() * 512;
    constexpr int NCH = DFF / 8, RUN = 8; const int NITEM = (tg / RUN) * NCH;
    for (int it = gt; it < NITEM; it += NGT) {
        const int ch = it % NCH, run = it / NCH, c0 = ch * 8, t0 = run * RUN;
        const u32x4 zero = {0u, 0u, 0u, 0u};
        u32x4 ra[RUN + 2], rb[RUN + 2];
#pragma unroll
        for (int i = 0; i < RUN + 2; ++i) {
            const int t = t0 - 1 + i;
            const bool ok = !((i == 0 && (t0 & (SEQ - 1)) == 0) || (i == RUN + 1 && ((t0 + RUN) & (SEQ - 1)) == 0));
            const bf16_t* p = U + (size_t)(ok ? t : t0) * DFF2 + c0;
            const u32x4 a = *(const u32x4*)p, b = *(const u32x4*)(p + DFF);
            ra[i] = ok ? a : zero; rb[i] = ok ? b : zero;
        }
        f32x4 wa[3][2], wb[3][2], ba[2], bb[2];
#pragma unroll
        for (int k = 0; k < 3; ++k) { wa[k][0] = *(const f32x4*)(cw + k * DFF2 + c0); wa[k][1] = *(const f32x4*)(cw + k * DFF2 + c0 + 4);
                                      wb[k][0] = *(const f32x4*)(cw + k * DFF2 + DFF + c0); wb[k][1] = *(const f32x4*)(cw + k * DFF2 + DFF + c0 + 4); }
        ba[0] = *(const f32x4*)(cb + c0); ba[1] = *(const f32x4*)(cb + c0 + 4); bb[0] = *(const f32x4*)(cb + DFF + c0); bb[1] = *(const f32x4*)(cb + DFF + c0 + 4);
#pragma unroll
        for (int i = 0; i < RUN; ++i) {
            float o[8];
#pragma unroll
            for (int e = 0; e < 8; ++e) {
                const float ua = bfe(ra[i], e) * wa[0][e >> 2][e & 3] + bfe(ra[i + 1], e) * wa[1][e >> 2][e & 3] + bfe(ra[i + 2], e) * wa[2][e >> 2][e & 3] + ba[e >> 2][e & 3];
                const float ub = bfe(rb[i], e) * wb[0][e >> 2][e & 3] + bfe(rb[i + 1], e) * wb[1][e >> 2][e & 3] + bfe(rb[i + 2], e) * wb[2][e >> 2][e & 3] + bb[e >> 2][e & 3];
                o[e] = gelu_tanh(ua) * ub;
            }
            u32x4 w; w.x = cvtpk(o[0], o[1]); w.y = cvtpk(o[2], o[3]); w.z = cvtpk(o[4], o[5]); w.w = cvtpk(o[6], o[7]);
            st16_wt(GA + (size_t)(t0 + i) * DFF + c0, w);
        }
    }
}
__device__ __forceinline__ void cvt_p(const float* P, bf16_t* PB, int tg, int wv) {
    const int gt = lbid() * 512 + ltid(wv), NGT = lgrid() * 512;
    for (int i = gt; i < tg * 256 / 8; i += NGT) { const f32x4 a = ((const f32x4*)P)[2 * i], b = ((const f32x4*)P)[2 * i + 1];
        u32x4 w; w.x = cvtpk(a.x, a.y); w.y = cvtpk(a.z, a.w); w.z = cvtpk(b.x, b.y); w.w = cvtpk(b.z, b.w); ((u32x4*)PB)[i] = w; }
}
__device__ __forceinline__ void dil_combine(const bf16_t* __restrict__ OD, const float* __restrict__ LSE, bf16_t* __restrict__ O, int r0, int nrows, int tg, int wv) {
    const int tid = ltid(wv);
#pragma unroll 8
    for (int i = tid; i < nrows * 32; i += 512) {
        const int t = r0 + (i >> 5), c8 = i & 31, slot = c8 >> 3;
        const float l0 = LSE[(size_t)t * 4 + slot], l1 = LSE[(size_t)(tg + t) * 4 + slot], l2 = LSE[(size_t)(2 * tg + t) * 4 + slot];
        const float mx = fmaxf(l0, fmaxf(l1, l2));
        float w0 = __builtin_amdgcn_exp2f(l0 - mx), w1 = __builtin_amdgcn_exp2f(l1 - mx), w2 = __builtin_amdgcn_exp2f(l2 - mx);
        const float inv = 1.0f / (w0 + w1 + w2); w0 *= inv; w1 *= inv; w2 *= inv;
        const u32x4 a = *(const u32x4*)(OD + (size_t)t * 256 + c8 * 8), b = *(const u32x4*)(OD + (size_t)(tg + t) * 256 + c8 * 8), c = *(const u32x4*)(OD + (size_t)(2 * tg + t) * 256 + c8 * 8);
        u32x4 w;
#pragma unroll
        for (int e = 0; e < 4; ++e) {
            const float lo = w0 * __builtin_bit_cast(float, a[e] << 16) + w1 * __builtin_bit_cast(float, b[e] << 16) + w2 * __builtin_bit_cast(float, c[e] << 16);
            const float hi = w0 * __builtin_bit_cast(float, a[e] & 0xffff0000u) + w1 * __builtin_bit_cast(float, b[e] & 0xffff0000u) + w2 * __builtin_bit_cast(float, c[e] & 0xffff0000u);
            w[e] = cvtpk(lo, hi);
        }
        *(u32x4*)(O + (size_t)t * 1024 + 256 + c8 * 8) = w;
    }
}

struct WaveAttn { f32x16 o0, o1; float m, l; };
__device__ __forceinline__ void wa_init(WaveAttn& st) {
#pragma unroll
    for (int r = 0; r < 16; ++r) { st.o0[r] = 0.f; st.o1[r] = 0.f; }
    st.m = -1.0e30f; st.l = 0.f;
}
__device__ __forceinline__ s16x4 vtr(LAS const unsigned char* p) { return __builtin_bit_cast(s16x4, __builtin_amdgcn_ds_read_tr16_b64_v4i16((LAS s16x4*)p)); }
__device__ __forceinline__ void softmax_pv(WaveAttn& st, f32x16 s, LAS const unsigned char* vb, int lane) {
    float mx = s[0];
#pragma unroll
    for (int r = 1; r < 16; ++r) mx = fmaxf(mx, s[r]);
    mx = xhalf_max(mx);
    if (__builtin_amdgcn_ballot_w64(mx > st.m + 8.0f) != 0ull) {
        const float mn = fmaxf(st.m, mx);
        const float alpha = __builtin_amdgcn_exp2f(st.m - mn);
        st.m = mn; st.l *= alpha;
#pragma unroll
        for (int r = 0; r < 16; ++r) { st.o0[r] *= alpha; st.o1[r] *= alpha; }
    }
    const float mn = st.m;
    float ps = 0.f;
#pragma unroll
    for (int r = 0; r < 16; ++r) { s[r] = __builtin_amdgcn_exp2f(s[r] - mn); ps += s[r]; }
    st.l += ps;
    u32x4 p0, p1;
    p0.x = cvtpk(s[0], s[1]); p0.y = cvtpk(s[2], s[3]); p0.z = cvtpk(s[4], s[5]); p0.w = cvtpk(s[6], s[7]);
    p1.x = cvtpk(s[8], s[9]); p1.y = cvtpk(s[10], s[11]); p1.z = cvtpk(s[12], s[13]); p1.w = cvtpk(s[14], s[15]);
    const bf16x8 pb0 = __builtin_bit_cast(bf16x8, p0), pb1 = __builtin_bit_cast(bf16x8, p1);
#define VFRAG(off) ({ const s16x4 lo_ = vtr(vb + (off)); const s16x4 hi_ = vtr(vb + (off) + 512); (bf16x8){lo_[0], lo_[1], lo_[2], lo_[3], hi_[0], hi_[1], hi_[2], hi_[3]}; })
    { const bf16x8 v00 = VFRAG(0), v01 = VFRAG(1024), v10 = VFRAG(2048), v11 = VFRAG(2048 + 1024);
      st.o0 = __builtin_amdgcn_mfma_f32_32x32x16_bf16(v00, pb0, st.o0, 0, 0, 0);
      st.o0 = __builtin_amdgcn_mfma_f32_32x32x16_bf16(v01, pb1, st.o0, 0, 0, 0);
      st.o1 = __builtin_amdgcn_mfma_f32_32x32x16_bf16(v10, pb0, st.o1, 0, 0, 0);
      st.o1 = __builtin_amdgcn_mfma_f32_32x32x16_bf16(v11, pb1, st.o1, 0, 0, 0); }
#undef VFRAG
}
__device__ __forceinline__ void store_o(const WaveAttn& st, float l_tot, bf16_t* orow, int hi) {
    const float inv = 1.0f / l_tot;
#pragma unroll
    for (int g = 0; g < 4; ++g) {
        u32x2 w0, w1;
        w0.x = cvtpk(st.o0[4 * g] * inv, st.o0[4 * g + 1] * inv); w0.y = cvtpk(st.o0[4 * g + 2] * inv, st.o0[4 * g + 3] * inv);
        w1.x = cvtpk(st.o1[4 * g] * inv, st.o1[4 * g + 1] * inv); w1.y = cvtpk(st.o1[4 * g + 2] * inv, st.o1[4 * g + 3] * inv);
        *(u32x2*)(orow + 8 * g + 4 * hi) = w0; *(u32x2*)(orow + 32 + 8 * g + 4 * hi) = w1;
    }
}
__device__ __forceinline__ int vtr_off(int lane) { const int hi = lane >> 5; return ((lane >> 4) & 1) * 32 + (lane & 3) * 8 + (4 * hi + ((lane & 15) >> 2)) * 64; }

constexpr int MLA_KP = 208;
constexpr int MLA_STAGE = 128 * MLA_KP + 16384;
__device__ __forceinline__ void softmax_pv_vf(WaveAttn& st, f32x16 s, const bf16x8 (&vf)[4]) {
    float mx = s[0];
#pragma unroll
    for (int r = 1; r < 16; ++r) mx = fmaxf(mx, s[r]);
    mx = xhalf_max(mx);
    if (__builtin_amdgcn_ballot_w64(mx > st.m + 8.0f) != 0ull) {
        const float mn = fmaxf(st.m, mx);
        const float alpha = __builtin_amdgcn_exp2f(st.m - mn);
        st.m = mn; st.l *= alpha;
#pragma unroll
        for (int r = 0; r < 16; ++r) { st.o0[r] *= alpha; st.o1[r] *= alpha; }
    }
    const float mn = st.m;
    float ps = 0.f;
#pragma unroll
    for (int r = 0; r < 16; ++r) { s[r] = __builtin_amdgcn_exp2f(s[r] - mn); ps += s[r]; }
    st.l += ps;
    u32x4 p0, p1;
    p0.x = cvtpk(s[0], s[1]); p0.y = cvtpk(s[2], s[3]); p0.z = cvtpk(s[4], s[5]); p0.w = cvtpk(s[6], s[7]);
    p1.x = cvtpk(s[8], s[9]); p1.y = cvtpk(s[10], s[11]); p1.z = cvtpk(s[12], s[13]); p1.w = cvtpk(s[14], s[15]);
    const bf16x8 pb0 = __builtin_bit_cast(bf16x8, p0), pb1 = __builtin_bit_cast(bf16x8, p1);
    st.o0 = __builtin_amdgcn_mfma_f32_32x32x16_bf16(vf[0], pb0, st.o0, 0, 0, 0);
    st.o1 = __builtin_amdgcn_mfma_f32_32x32x16_bf16(vf[2], pb0, st.o1, 0, 0, 0);
    st.o0 = __builtin_amdgcn_mfma_f32_32x32x16_bf16(vf[1], pb1, st.o0, 0, 0, 0);
    st.o1 = __builtin_amdgcn_mfma_f32_32x32x16_bf16(vf[3], pb1, st.o1, 0, 0, 0);
}
__device__ __forceinline__ void mla_phase2(const bf16_t* QKV, bf16_t* O, LAS unsigned char* lds, int nseq, int wv) {
    const int tid = ltid(wv), lane = tid & 63, wave = tid >> 6, r32 = lane & 31, hi = lane >> 5;
    const int voff = vtr_off(lane);
    const int G_ = lgrid(), b_ = lbid(), npair = nseq * 4, nunit = npair * 16;
    for (int u = b_; u < nunit; u += G_) {
        const int sh = (npair == 16) ? ((u & 7) + 8 * ((u >> 3) & 1)) : (u % npair), qb = (npair == 16) ? (u >> 4) : (u / npair);
        const int h = sh & 3, seq = sh >> 2;
        const size_t s0 = (size_t)seq * SEQ;
        const size_t rowa = s0 + qb * 512 + wave * 64 + r32, rowb = rowa + 32;
        bf16x8 qa[6], qb2[6];
#pragma unroll
        for (int ds = 0; ds < 6; ++ds) { qa[ds] = *(const bf16x8*)(QKV + rowa * 1024 + h * 96 + hi * 8 + ds * 16); qb2[ds] = *(const bf16x8*)(QKV + rowb * 1024 + h * 96 + hi * 8 + ds * 16); }
        WaveAttn sta, stb; wa_init(sta); wa_init(stb);
        const bf16_t* kbase = QKV + s0 * 1024 + 384 + h * 96; const bf16_t* vbase = QKV + s0 * 1024 + 768 + h * 64;
        int kso[4], vso[2];
#pragma unroll
        for (int i = 0; i < 4; ++i) { const int o = (wave + 8 * i) * 1024 + 16 * lane, row = o / MLA_KP, cb = o - row * MLA_KP; kso[i] = (row < 128 ? row : 0) * 1024 + (cb < 192 ? cb : 0) / 2; }
#pragma unroll
        for (int i = 0; i < 2; ++i) { const int p = wave + 8 * i; vso[i] = ((p >> 2) * 32 + (p & 1) * 16 + (lane >> 2)) * 1024 + ((p >> 1) & 1) * 32 + (lane & 3) * 8; }
#define MLA_LOAD(kt, buf) do { LAS unsigned char* kb_ = lds + (buf) * MLA_STAGE; LAS unsigned char* vb_ = kb_ + 128 * MLA_KP; \
        _Pragma("unroll") for (int i = 0; i < 4; ++i) if (wave + 8 * i < 26) __builtin_amdgcn_global_load_lds((const unsigned*)(kbase + (size_t)(kt) * 128 * 1024 + kso[i]), (LAS unsigned*)(kb_ + (wave + 8 * i) * 1024), 16, 0, 0); \
        _Pragma("unroll") for (int i = 0; i < 2; ++i) __builtin_amdgcn_global_load_lds((const unsigned*)(vbase + (size_t)(kt) * 128 * 1024 + vso[i]), (LAS unsigned*)(vb_ + (wave + 8 * i) * 1024), 16, 0, 0); } while (0)
        __syncthreads();
        MLA_LOAD(0, 0);
        asm volatile("s_waitcnt vmcnt(0)" ::: "memory"); __syncthreads();
        for (int kt = 0; kt < SEQ / 128; ++kt) {
            if (kt + 1 < SEQ / 128) MLA_LOAD(kt + 1, (kt + 1) & 1);
            LAS const unsigned char* kb = lds + (kt & 1) * MLA_STAGE; LAS const unsigned char* vbuf = kb + 128 * MLA_KP;
#pragma unroll
            for (int sub = 0; sub < 4; ++sub) {
                f32x16 sa, sb;
#pragma unroll
                for (int r = 0; r < 16; ++r) { sa[r] = 0.f; sb[r] = 0.f; }
                LAS const unsigned char* kp = kb + (sub * 32 + r32) * MLA_KP + hi * 16;
                __builtin_amdgcn_s_setprio(1);
#pragma unroll
                for (int ds = 0; ds < 6; ++ds) { const bf16x8 kf = *(LAS const bf16x8*)(kp + ds * 32);
                    sa = __builtin_amdgcn_mfma_f32_32x32x16_bf16(kf, qa[ds], sa, 0, 0, 0); sb = __builtin_amdgcn_mfma_f32_32x32x16_bf16(kf, qb2[ds], sb, 0, 0, 0); }
                __builtin_amdgcn_s_setprio(0);
                LAS const unsigned char* vb_ = vbuf + sub * 4096 + voff;
                bf16x8 vf[4];
#pragma unroll
                for (int i = 0; i < 4; ++i) { const int off = (i >> 1) * 2048 + (i & 1) * 1024; const s16x4 lo_ = vtr(vb_ + off), hi_ = vtr(vb_ + off + 512);
                    vf[i] = (bf16x8){lo_[0], lo_[1], lo_[2], lo_[3], hi_[0], hi_[1], hi_[2], hi_[3]}; }
                softmax_pv_vf(sta, sa, vf); softmax_pv_vf(stb, sb, vf);
            }
            asm volatile("s_waitcnt vmcnt(0)" ::: "memory"); __syncthreads();
        }
#undef MLA_LOAD
        store_o(sta, xhalf_sum(sta.l), O + rowa * 1024 + h * 64, hi);
        store_o(stb, xhalf_sum(stb.l), O + rowb * 1024 + h * 64, hi);
    }
}
__device__ __forceinline__ void mla_phase(const bf16_t* QKV, bf16_t* O, LAS unsigned char* lds, int nseq, int wv) {
    const int tid = ltid(wv), lane = tid & 63, wave = tid >> 6, r32 = lane & 31, hi = lane >> 5;
    const int voff = vtr_off(lane);
    const int G_ = lgrid(), b_ = lbid(), npair = nseq * 4, nunit = npair * 32;
    for (int i_ = 0; i_ * G_ < nunit; ++i_) {
        int sh, qb;
        if (G_ == 256) { sh = (b_ & 7) + 8 * i_; qb = b_ >> 3; } else { const int u = b_ + i_ * G_; sh = u % npair; qb = u / npair; }
        if (sh >= npair || qb >= 32) continue;
        const int h = sh & 3, seq = sh >> 2;
        const size_t s0 = (size_t)seq * SEQ;
        const bf16_t* qrow = QKV + (s0 + qb * 256 + wave * 32 + r32) * 1024 + h * 96 + hi * 8;
        bf16x8 q[6];
#pragma unroll
        for (int ds = 0; ds < 6; ++ds) q[ds] = *(const bf16x8*)(qrow + ds * 16);
        WaveAttn st; wa_init(st);
        const bf16_t* kbase = QKV + s0 * 1024 + 384 + h * 96; const bf16_t* vbase = QKV + s0 * 1024 + 768 + h * 64;
        int kso[4], vso[2];
#pragma unroll
        for (int i = 0; i < 4; ++i) { const int o = (wave + 8 * i) * 1024 + 16 * lane, row = o / MLA_KP, cb = o - row * MLA_KP; kso[i] = (row < 128 ? row : 0) * 1024 + (cb < 192 ? cb : 0) / 2; }
#pragma unroll
        for (int i = 0; i < 2; ++i) { const int p = wave + 8 * i; vso[i] = ((p >> 2) * 32 + (p & 1) * 16 + (lane >> 2)) * 1024 + ((p >> 1) & 1) * 32 + (lane & 3) * 8; }
#define MLA_LOAD(kt, buf) do { LAS unsigned char* kb_ = lds + (buf) * MLA_STAGE; LAS unsigned char* vb_ = kb_ + 128 * MLA_KP; \
        _Pragma("unroll") for (int i = 0; i < 4; ++i) if (wave + 8 * i < 26) __builtin_amdgcn_global_load_lds((const unsigned*)(kbase + (size_t)(kt) * 128 * 1024 + kso[i]), (LAS unsigned*)(kb_ + (wave + 8 * i) * 1024), 16, 0, 0); \
        _Pragma("unroll") for (int i = 0; i < 2; ++i) __builtin_amdgcn_global_load_lds((const unsigned*)(vbase + (size_t)(kt) * 128 * 1024 + vso[i]), (LAS unsigned*)(vb_ + (wave + 8 * i) * 1024), 16, 0, 0); } while (0)
        __syncthreads();
        MLA_LOAD(0, 0);
        asm volatile("s_waitcnt vmcnt(0)" ::: "memory"); __syncthreads();
        for (int kt = 0; kt < SEQ / 128; ++kt) {
            if (kt + 1 < SEQ / 128) MLA_LOAD(kt + 1, (kt + 1) & 1);
            LAS const unsigned char* kb = lds + (kt & 1) * MLA_STAGE; LAS const unsigned char* vbuf = kb + 128 * MLA_KP;
#pragma unroll
            for (int sub = 0; sub < 4; ++sub) {
                f32x16 s;
#pragma unroll
                for (int r = 0; r < 16; ++r) s[r] = 0.f;
                LAS const unsigned char* kp = kb + (sub * 32 + r32) * MLA_KP + hi * 16;
#pragma unroll
                for (int ds = 0; ds < 6; ++ds) { const bf16x8 kf = *(LAS const bf16x8*)(kp + ds * 32); s = __builtin_amdgcn_mfma_f32_32x32x16_bf16(kf, q[ds], s, 0, 0, 0); }
                softmax_pv(st, s, vbuf + sub * 4096 + voff, lane);
            }
            asm volatile("s_waitcnt vmcnt(0)" ::: "memory"); __syncthreads();
        }
#undef MLA_LOAD
        const float lt = xhalf_sum(st.l);
        store_o(st, lt, O + (s0 + qb * 256 + wave * 32 + r32) * 1024 + h * 64, hi);
    }
}

constexpr int LDS_TSWA = 90112  , LDS_TDIL = 95232  , LDS_TNA = 107520  ;
__device__ __forceinline__ void ldk4(bf16x8 (&kf)[4], const bf16_t* rowp) {
#pragma unroll
    for (int ds = 0; ds < 4; ++ds) kf[ds] = *(const bf16x8*)(rowp + ds * 16);
}
__device__ __forceinline__ void stv4(LAS unsigned char* vimg, const u32x4 (&vr)[4], int lane) {
    const int ch = lane & 7;
#pragma unroll
    for (int i = 0; i < 4; ++i) { const int row = (lane >> 3) + 8 * i; *(LAS u32x4*)(vimg + (ch >> 2) * 2048 + row * 64 + (ch & 3) * 16) = vr[i]; }
}
__device__ __forceinline__ f32x16 qk4(const bf16x8 (&kf)[4], const bf16x8 (&q)[4]) {
    f32x16 s;
#pragma unroll
    for (int r = 0; r < 16; ++r) s[r] = 0.f;
#pragma unroll
    for (int ds = 0; ds < 4; ++ds) s = __builtin_amdgcn_mfma_f32_32x32x16_bf16(kf[ds], q[ds], s, 0, 0, 0);
    return s;
}
constexpr float SC64 = 0.125f * LOG2E;

#define SM_TILE_BODY(TA, TB, EDGE) do { \
        bf16x8 kf[4]; u32x4 vr[4]; \
        SM_LOAD(cur_arg); SM_LOADV(cur_arg); (void)has_next; (void)next_arg; \
        _Pragma("unroll") for (int i = 0; i < 4; ++i) kf[i] = kfN[i]; \
        f32x16 sa = qk4(kf, qa), sb = qk4(kf, qb); \
        _Pragma("unroll") for (int r = 0; r < 16; ++r) { sa[r] = sa[r] * SC64 + (TA); sb[r] = sb[r] * SC64 + (TB); } \
        EDGE; \
        stv4(vimg, vr, lane); \
        bf16x8 vf_[4];     \
        _Pragma("unroll") for (int i = 0; i < 4; ++i) { const int off_ = (i >> 1) * 2048 + (i & 1) * 1024; const s16x4 lo_ = vtr(vimg + voff + off_), hi_ = vtr(vimg + voff + off_ + 512); \
            vf_[i] = (bf16x8){lo_[0], lo_[1], lo_[2], lo_[3], hi_[0], hi_[1], hi_[2], hi_[3]}; } \
        softmax_pv_vf(sta, sa, vf_); softmax_pv_vf(stb, sb, vf_); } while (0)

__device__ __forceinline__ void swa_item(int item, const bf16_t* Z, bf16_t* O, const float* sink, LAS unsigned char* lds, int lane, int wave) {
    const int r32 = lane & 31, hi = lane >> 5, kvh = item & 1, t0 = (item >> 1) * 32, s0 = t0 & ~(SEQ - 1), ha = 2 * kvh;
    LAS unsigned char* vimg = lds + wave * 4096; const int voff = vtr_off(lane);
    LAS const float* taba = (LAS const float*)(lds + LDS_TSWA) + ha * 320 + (4 * hi - r32 + 32);
    LAS const float* tabb = taba + 320;
    const int tq = t0 + r32;
    bf16x8 qa[4], qb[4]; ldk4(qa, Z + (size_t)tq * ZC + COL_C + ha * 64 + hi * 8); ldk4(qb, Z + (size_t)tq * ZC + COL_C + (ha + 1) * 64 + hi * 8);
    WaveAttn sta, stb; wa_init(sta); wa_init(stb);
    int jlo = 0, jhi = 9;
    while (t0 - 128 + 32 * jlo + 31 < s0) ++jlo;
    while (t0 - 128 + 32 * (jhi - 1) >= s0 + SEQ) --jhi;
    const bf16_t* Zk = Z + COL_C + 256 + kvh * 64 + hi * 8; const bf16_t* Zv = Z + COL_C + 384 + kvh * 64 + (lane & 7) * 8;
    bf16x8 kfN[4];
#define SM_LOAD(j_) do { const int kb_ = t0 - 128 + 32 * (j_); ldk4(kfN, Zk + (size_t)clampi(kb_ + r32, s0, s0 + SEQ - 1) * ZC); } while (0)
#define SM_LOADV(j_) do { const int kb_ = t0 - 128 + 32 * (j_); _Pragma("unroll") for (int i = 0; i < 4; ++i) vr[i] = *(const u32x4*)(Zv + (size_t)clampi(kb_ + (lane >> 3) + 8 * i, s0, s0 + SEQ - 1) * ZC); } while (0)
    for (int j = jlo; j < jhi; ++j) {
        const int kb = t0 - 128 + 32 * j; const bool has_next = j + 1 < jhi; const int next_arg = j + 1, cur_arg = j;
        LAS const float* tja = taba + 32 * j; LAS const float* tjb = tabb + 32 * j;
        SM_TILE_BODY(tja[(r & 3) + 8 * (r >> 2)], tjb[(r & 3) + 8 * (r >> 2)],
            if (kb < s0 || kb + 31 >= s0 + SEQ) { _Pragma("unroll") for (int r = 0; r < 16; ++r) { const int key = kb + crow(r, hi); if (key < s0 || key >= s0 + SEQ) { sa[r] = NEGBIG; sb[r] = NEGBIG; } } });
    }
#undef SM_LOAD
#undef SM_LOADV
    const float lta = xhalf_sum(sta.l) + __builtin_amdgcn_exp2f(sink[ha] * LOG2E - sta.m);
    const float ltb = xhalf_sum(stb.l) + __builtin_amdgcn_exp2f(sink[ha + 1] * LOG2E - stb.m);
    store_o(sta, lta, O + (size_t)tq * 1024 + 512 + ha * 64, hi);
    store_o(stb, ltb, O + (size_t)tq * 1024 + 512 + (ha + 1) * 64, hi);
}
__device__ __forceinline__ void dil_item(int item, const bf16_t* Z, bf16_t* OD, float* LSE, LAS unsigned char* lds, int lane, int wave, int tg) {
    const int r32 = lane & 31, hi = lane >> 5;
    const int tau = item & 127, slot = (item >> 7) & 3, gs = item >> 9, gi = gs % 3, seq = gs / 3;
    const int dsh = gi * 2, dil = 1 << dsh, sub = SEQ >> dsh, tpr = 128 >> dsh;
    const int res = tau / tpr, m0 = (tau % tpr) * 64, s0 = seq * SEQ;
    LAS unsigned char* vimg = lds + wave * 4096; const int voff = vtr_off(lane);
    LAS const float* taba = (LAS const float*)(lds + LDS_TDIL) + (gi * 4 + slot) * 256 + (4 * hi - r32 + 64);
    LAS const float* tabb = taba - 32;
    const int cq = COL_B + gi * 768 + slot * 64;
    const int tqa = s0 + (m0 + r32) * dil + res, tqb = tqa + 32 * dil;
    bf16x8 qa[4], qb[4]; ldk4(qa, Z + (size_t)tqa * ZC + cq + hi * 8); ldk4(qb, Z + (size_t)tqb * ZC + cq + hi * 8);
    WaveAttn sta, stb; wa_init(sta); wa_init(stb);
    int jlo = 0, jhi = 6;
    while (m0 - 64 + 32 * jlo + 31 < 0) ++jlo;
    while (m0 - 64 + 32 * (jhi - 1) >= sub) --jhi;
    const bf16_t* Zk = Z + (size_t)(s0 + res) * ZC + cq + 256 + hi * 8; const bf16_t* Zv = Z + (size_t)(s0 + res) * ZC + cq + 512 + (lane & 7) * 8;
    bf16x8 kfN[4];
#define SM_LOAD(j_) do { const int mb_ = m0 - 64 + 32 * (j_); ldk4(kfN, Zk + (size_t)(clampi(mb_ + r32, 0, sub - 1) * dil) * ZC); } while (0)
#define SM_LOADV(j_) do { const int mb_ = m0 - 64 + 32 * (j_); _Pragma("unroll") for (int i = 0; i < 4; ++i) vr[i] = *(const u32x4*)(Zv + (size_t)(clampi(mb_ + (lane >> 3) + 8 * i, 0, sub - 1) * dil) * ZC); } while (0)
    for (int j = jlo; j < jhi; ++j) {
        const int mb = m0 - 64 + 32 * j; const bool has_next = j + 1 < jhi; const int next_arg = j + 1, cur_arg = j;
        LAS const float* tja = taba + 32 * j; LAS const float* tjb = tabb + 32 * j;
        SM_TILE_BODY(tja[(r & 3) + 8 * (r >> 2)], tjb[(r & 3) + 8 * (r >> 2)],
            if (mb < 0 || mb + 31 >= sub) { _Pragma("unroll") for (int r = 0; r < 16; ++r) { const int mk = mb + crow(r, hi); if (mk < 0 || mk >= sub) { sa[r] = NEGBIG; sb[r] = NEGBIG; } } });
    }
#undef SM_LOAD
#undef SM_LOADV
    const float lta = xhalf_sum(sta.l), ltb = xhalf_sum(stb.l);
    store_o(sta, lta, OD + ((size_t)gi * tg + tqa) * 256 + slot * 64, hi);
    store_o(stb, ltb, OD + ((size_t)gi * tg + tqb) * 256 + slot * 64, hi);
    if (hi == 0) { LSE[((size_t)gi * tg + tqa) * 4 + slot] = sta.m + __builtin_amdgcn_logf(lta); LSE[((size_t)gi * tg + tqb) * 4 + slot] = stb.m + __builtin_amdgcn_logf(ltb); }
}
__device__ __forceinline__ void na_item(int item, const bf16_t* Z, bf16_t* O, LAS unsigned char* lds, int lane, int wave) {
    const int r32 = lane & 31, hi = lane >> 5;
    const int h = item & 3, cb = (item >> 2) & 3, rq = (item >> 4) & 31, seq = item >> 9;
    const int R = 4 * rq, s0 = seq * SEQ, stc = clampi(16 * cb - 8, 0, 32);
    LAS unsigned char* vimg = lds + wave * 4096; const int voff = vtr_off(lane);
    LAS const float* tab = (LAS const float*)(lds + LDS_TNA) + h * 512;
    const int qrowa = R + (r32 >> 4), qrowb = qrowa + 2, qc = 16 * cb + (r32 & 15), tqa = s0 + qrowa * 64 + qc, tqb = tqa + 128;
    const int srqa = clampi(qrowa - 4, 0, 120), srqb = clampi(qrowb - 4, 0, 120), scq = clampi(qc - 8, 0, 48);
    const int cbase = stc + 4 * hi - qc + 15, vbase = stc + 4 * hi - scq;
#define NA_CIDX(r) (((unsigned)(vbase + ((r) & 3) + 8 * ((r) >> 2)) < 16u) ? (cbase + ((r) & 3) + 8 * ((r) >> 2)) : 31)
    bf16x8 qa[4], qb[4]; ldk4(qa, Z + (size_t)tqa * ZC + COL_D + h * 64 + hi * 8); ldk4(qb, Z + (size_t)tqb * ZC + COL_D + h * 64 + hi * 8);
    WaveAttn sta, stb; wa_init(sta); wa_init(stb);
    const int kr0 = clampi(R - 4, 0, 120), kr1 = clampi(R + 3 - 4, 0, 120) + 7;
    const bf16_t* Zk = Z + (size_t)(s0 + stc + r32) * ZC + COL_D + 256 + h * 64 + hi * 8; const bf16_t* Zv = Z + (size_t)(s0 + stc + (lane >> 3)) * ZC + COL_D + 512 + h * 64 + (lane & 7) * 8;
    bf16x8 kfN[4];
#define SM_LOAD(kr_) do { ldk4(kfN, Zk + (size_t)((kr_) * 64) * ZC); } while (0)
#define SM_LOADV(kr_) do { _Pragma("unroll") for (int i = 0; i < 4; ++i) vr[i] = *(const u32x4*)(Zv + (size_t)((kr_) * 64 + 8 * i) * ZC); } while (0)
    for (int krow = kr0; krow <= kr1; ++krow) {
        const bool has_next = krow + 1 <= kr1; const int next_arg = krow + 1, cur_arg = krow;
        LAS const float* tra = tab + ((krow >= srqa && krow < srqa + 8) ? clampi(krow - qrowa + 7, 0, 14) : 15) * 32;
        LAS const float* trb = tab + ((krow >= srqb && krow < srqb + 8) ? clampi(krow - qrowb + 7, 0, 14) : 15) * 32;
        SM_TILE_BODY(tra[NA_CIDX(r)], trb[NA_CIDX(r)], (void)0);
    }
#undef SM_LOAD
#undef SM_LOADV
    const float lta = xhalf_sum(sta.l), ltb = xhalf_sum(stb.l);
    store_o(sta, lta, O + (size_t)tqa * 1024 + 768 + h * 64, hi);
    store_o(stb, ltb, O + (size_t)tqb * 1024 + 768 + h * 64, hi);
#undef NA_CIDX
}
#undef SM_TILE_BODY
__device__ __forceinline__ void small_attn_phase(ArgP ap, int layer, const bf16_t* Z, bf16_t* O, bf16_t* OD, float* LSE, LAS unsigned char* lds, int tg, int wv) {
    const int tid = ltid(wv), lane = tid & 63, wave = tid >> 6;
    __syncthreads();
    const float* tgl = (const float*)(ap->ws + WS_TAB);
    for (int i = tid; i < 4 * 320; i += 512) { const int h_ = i / 320, off = i % 320 - 160; ((LAS float*)(lds + LDS_TSWA))[i] = (off >= -128 && off <= 128) ? tgl[h_ * 257 + off + 128] : NEGBIG; }
    for (int i = tid; i < 12 * 256; i += 512) { const int hh = i >> 8, d = (i & 255) - 128; ((LAS float*)(lds + LDS_TDIL))[i] = (d >= -64 && d <= 64) ? tgl[4 * 257 + hh * 129 + d + 64] : NEGBIG; }
    const float* rpb = ap->in[I_RPB] + (size_t)layer * 4 * 465;
    for (int i = tid; i < 4 * 512; i += 512) { const int h_ = i >> 9, rr = (i >> 5) & 15, cc = i & 31; ((LAS float*)(lds + LDS_TNA))[i] = (rr < 15 && cc < 31) ? rpb[h_ * 465 + rr * 31 + cc] * LOG2E : NEGBIG; }
    __syncthreads();
    const int G_ = lgrid(), b_ = lbid(), vb = (G_ % 8 == 0) ? (b_ % 8) * (G_ / 8) + b_ / 8 : b_;
    const int gw = vb * 8 + wave, NGW = G_ * 8;
    const float* sink = ap->in[I_SINK] + layer * 4;
    const int nseq = tg / SEQ, n_dil = nseq * 1536, n_swa = nseq * 512, n_na = nseq * 512;
    for (int it = gw; it < n_dil + n_swa + n_na; it += NGW) {
        if (it < n_dil) dil_item(it, Z, OD, LSE, lds, lane, wave, tg);
        else if (it < n_dil + n_swa) swa_item(it - n_dil, Z, O, sink, lds, lane, wave);
        else na_item(it - n_dil - n_swa, Z, O, lds, lane, wave);
    }
}

__device__ __forceinline__ void branch_phase(LAS unsigned char* lds, const bf16_t* __restrict__ O, const bf16_t* __restrict__ Wb, const bf16_t* __restrict__ Gt, bf16_t* __restrict__ MG, int tg, int wv) {
    const int tid = ltid(wv), lane = tid & 63, wave = tid >> 6, wm = wave >> 2, wn = wave & 3, fr = lane & 15, fq = lane >> 4;
    const int G_ = lgrid(), b_ = lbid(), vb = (G_ % 8 == 0) ? (b_ % 8) * (G_ / 8) + b_ / 8 : b_;
    const int ntile = (tg / 128) * 4;
    constexpr int STG = 49152;
    int pR[2], pC[2];
#pragma unroll
    for (int i = 0; i < 2; ++i) pg8::stage_rc(tid * 16 + i * 8192, pR[i], pC[i]);
    const int aoff = pg8::lds_byte(wm * 64 + fr, fq * 8), boff = 16384 + (wn >> 1) * 16384 + pg8::lds_byte((wn & 1) * 64 + fr, fq * 8);
    __syncthreads();
    for (int tile = vb; tile < ntile; tile += G_) {
        const int rt = tile >> 2, ct = tile & 3;
        const bf16_t* Ab = O + (size_t)(rt * 128) * 1024;
        u32x2 sum[4][4];
#pragma unroll
        for (int m = 0; m < 4; ++m)
#pragma unroll
            for (int n = 0; n < 4; ++n) sum[m][n] = (u32x2){0u, 0u};
#define BR_LOAD(c_, s_) do { const int j_ = (c_) >> 2, kc_ = (c_) & 3; LAS unsigned char* sb_ = lds + (s_) * STG + wave * 1024; \
        _Pragma("unroll") for (int i = 0; i < 2; ++i) { \
            __builtin_amdgcn_global_load_lds((const unsigned*)(Ab + (size_t)pR[i] * 1024 + j_ * 256 + kc_ * 64 + pC[i]), (LAS unsigned*)(sb_ + i * 8192), 16, 0, 0); \
            __builtin_amdgcn_global_load_lds((const unsigned*)(Wb + (size_t)(j_ * 1024 + ct * 256 + pR[i]) * 256 + kc_ * 64 + pC[i]), (LAS unsigned*)(sb_ + 16384 + i * 8192), 16, 0, 0); \
            __builtin_amdgcn_global_load_lds((const unsigned*)(Wb + (size_t)(j_ * 1024 + ct * 256 + 128 + pR[i]) * 256 + kc_ * 64 + pC[i]), (LAS unsigned*)(sb_ + 32768 + i * 8192), 16, 0, 0); } } while (0)
        BR_LOAD(0, 0);
        asm volatile("s_waitcnt vmcnt(0)" ::: "memory"); __syncthreads();
        for (int j = 0; j < 4; ++j) {
            u32x2 gv[4][4];
            f32x4 acc[4][4];
#pragma unroll
            for (int m = 0; m < 4; ++m)
#pragma unroll
                for (int n = 0; n < 4; ++n) acc[m][n] = (f32x4){0.f, 0.f, 0.f, 0.f};
            for (int kc = 0; kc < 4; ++kc) {
                const int c = j * 4 + kc;
                if (c + 1 < 16) BR_LOAD(c + 1, (c + 1) & 1);
                if (kc == 3) {
                    const bf16_t* gp = Gt + (size_t)(rt * 128 + wm * 64 + fr) * ZC + j * 1024 + ct * 256 + wn * 64 + 4 * fq;
#pragma unroll
                    for (int m = 0; m < 4; ++m)
#pragma unroll
                        for (int n = 0; n < 4; ++n) gv[m][n] = *(const u32x2*)(gp + (size_t)m * 16 * ZC + n * 16);
                }
                LAS const unsigned char* st = lds + (c & 1) * STG;
#pragma unroll
                for (int k = 0; k < 2; ++k) {
                    __builtin_amdgcn_sched_barrier(0);
                    bf16x8 af[4], bfr[4];
#pragma unroll
                    for (int m = 0; m < 4; ++m) af[m] = *(LAS const bf16x8*)(st + aoff + m * 2048 + k * 1024);
#pragma unroll
                    for (int n = 0; n < 4; ++n) bfr[n] = *(LAS const bf16x8*)(st + boff + n * 2048 + k * 1024);
#pragma unroll
                    for (int m = 0; m < 4; ++m)
#pragma unroll
                        for (int n = 0; n < 4; ++n) acc[m][n] = __builtin_amdgcn_mfma_f32_16x16x32_bf16(bfr[n], af[m], acc[m][n], 0, 0, 0);
                }
                asm volatile("s_waitcnt vmcnt(0)" ::: "memory"); __syncthreads();
            }
#pragma unroll
            for (int m = 0; m < 4; ++m)
#pragma unroll
                for (int n = 0; n < 4; ++n) { const u32x2 g = gv[m][n], sp = sum[m][n];
                    const float s0_ = __builtin_bit_cast(float, sp.x << 16) + acc[m][n][0] * __builtin_bit_cast(float, g.x << 16), s1_ = __builtin_bit_cast(float, sp.x & 0xffff0000u) + acc[m][n][1] * __builtin_bit_cast(float, g.x & 0xffff0000u);
                    const float s2_ = __builtin_bit_cast(float, sp.y << 16) + acc[m][n][2] * __builtin_bit_cast(float, g.y << 16), s3_ = __builtin_bit_cast(float, sp.y & 0xffff0000u) + acc[m][n][3] * __builtin_bit_cast(float, g.y & 0xffff0000u);
                    sum[m][n] = (u32x2){cvtpk(s0_, s1_), cvtpk(s2_, s3_)}; }
        }
#undef BR_LOAD
#pragma unroll
        for (int m = 0; m < 4; ++m)
#pragma unroll
            for (int n = 0; n < 4; ++n) { const u32x2 w = sum[m][n];
                *(u32x2*)(MG + (size_t)(rt * 128 + wm * 64 + m * 16 + fr) * 1024 + ct * 256 + wn * 64 + n * 16 + 4 * fq) = w; }
    }
}

#define XB_TMO      128
#define XB_XCNT(j)  (256  + 64 * (j))
#define XB_XSUB(j)  (1280 + 64 * (j))
#define XB_XGEN(j)  (2304 + 64 * (j))
#define XB_TOP      3328
#define XB_TOPGEN   3392
#define XCD_BAR_WORDS 3456
#define XB_SPIN_CAP (1u << 18)
__device__ __forceinline__ unsigned xb_ld(unsigned* p)              { return __hip_atomic_load(p, __ATOMIC_RELAXED, __HIP_MEMORY_SCOPE_AGENT); }
__device__ __forceinline__ unsigned xb_add(unsigned* p, unsigned v) { return __hip_atomic_fetch_add(p, v, __ATOMIC_RELAXED, __HIP_MEMORY_SCOPE_AGENT); }
__device__ __forceinline__ unsigned xb_xcc_id() { return (unsigned)__builtin_amdgcn_s_getreg((3 << 11) | 20) & 0xFu; }
#define XB_SPIN(cond, bar) do { unsigned _sp = 0; while (cond) { __builtin_amdgcn_s_sleep(1); \
    if ((++_sp & 255u) == 0u) { if (xb_ld(&(bar)[XB_TMO])) break; if (_sp > XB_SPIN_CAP) { atomicAdd(&(bar)[XB_TMO], 1u); break; } } } } while (0)
__device__ __forceinline__ void xcd_barrier_complete(unsigned* bar, unsigned x, unsigned G, unsigned& nloc, unsigned& nx) {
    unsigned sum, cnt, mine, sp = 0u;
    for (;;) {
        sum = 0u; cnt = 0u; mine = 0u;
#pragma unroll
        for (unsigned j = 0; j < 16; ++j) { const unsigned c = xb_ld(&bar[XB_XCNT(j)]); sum += c; cnt += (c > 0u) ? 1u : 0u; mine = (j == x) ? c : mine; }
        if (sum == G) break;
        __builtin_amdgcn_s_sleep(1);
        if ((++sp & 255u) == 0u) { if (xb_ld(&bar[XB_TMO])) break; if (sp > XB_SPIN_CAP) { atomicAdd(&bar[XB_TMO], 1u); break; } }
    }
    nloc = mine > 0u ? mine : 1u; nx = cnt > 0u ? cnt : 1u;
}
__device__ __forceinline__ void xcd_barrier(unsigned* bar, volatile LAS unsigned* st, int tid) {
    asm volatile("s_waitcnt vmcnt(0)" ::: "memory");
    __syncthreads();
    if (tid == 0) {
        __builtin_amdgcn_s_waitcnt(0);
        const unsigned x = xb_xcc_id();
        unsigned nloc = st[0], nx = st[1];
        if (nloc == 0u) { xcd_barrier_complete(bar, x, (unsigned)lgrid(), nloc, nx); st[0] = nloc; st[1] = nx; }
        const unsigned old = xb_add(&bar[XB_XSUB(x)], 1u);
        const unsigned gen = old / nloc;
        if (old + 1u == (gen + 1u) * nloc) {
            __builtin_amdgcn_fence(__ATOMIC_RELEASE, "agent");
            asm volatile("s_waitcnt vmcnt(0)" ::: "memory");
            const unsigned og = xb_add(&bar[XB_TOP], 1u);
            const unsigned tg = og / nx;
            if (og + 1u == (tg + 1u) * nx) xb_add(&bar[XB_TOPGEN], 1u);
            else XB_SPIN(xb_ld(&bar[XB_TOPGEN]) == tg, bar);
            __builtin_amdgcn_fence(__ATOMIC_ACQUIRE, "agent");
            xb_add(&bar[XB_XGEN(x)], 1u);
            asm volatile("s_waitcnt vmcnt(0)" ::: "memory");
        } else {
            XB_SPIN(xb_ld(&bar[XB_XGEN(x)]) == gen, bar);
            __builtin_amdgcn_fence(__ATOMIC_ACQUIRE, "agent");
            asm volatile("s_waitcnt vmcnt(0)" ::: "memory");
        }
    }
    __syncthreads();
}

constexpr int LDS_BYTES = 147456;
constexpr int PH_PER = 16;
constexpr int N_STEPS = 1 + NGROUP * DEPTH * PH_PER;

#ifndef ONLYM
#define ONLYM 0x1ffff
#endif
__global__ void __launch_bounds__(512, 2) fwd_kernel(Args a) {
    extern __shared__ __attribute__((aligned(16))) unsigned char lds_raw[];
    LAS unsigned char* lds = (LAS unsigned char*)lds_raw;
    cg::grid_group grid = cg::this_grid();
#define CASE(n) case n: if constexpr ((ONLYM >> (n)) & 1)
    const int s_lo = a.lo, s_hi = a.hi;
    const int wv = __builtin_amdgcn_readfirstlane((int)threadIdx.x >> 6);
    volatile LAS unsigned* bst = (volatile LAS unsigned*)(lds + 131072 + 1024);
    if (ltid(wv) == 0) { bst[0] = 0u; bst[1] = 0u; (void)xb_add((unsigned*)(a.ws + WS_BAR) + XB_XCNT(xb_xcc_id()), 1u); }
    __syncthreads();
    if (s_lo == 0) {
        ArgP ap0 = (ArgP)__builtin_amdgcn_kernarg_segment_ptr(); asm volatile("" : "+s"(ap0));
        if constexpr ((ONLYM >> 16) & 1) prologue(ap0, lds, wv);
        if (s_hi > 1) grid.sync();
    }
    for (int s = (s_lo > 1 ? s_lo : 1); s < s_hi; ++s) {
        const int G = lgrid();
        ArgP ap = (ArgP)__builtin_amdgcn_kernarg_segment_ptr(); asm volatile("" : "+s"(ap));
        unsigned char* ws = ap->ws;
        {
            const int idx = s - 1, ph = idx & 15, L = (idx >> 4) & 3, g = idx >> 6;
            if ((ph == 15 && L != DEPTH - 1) || (ph == 0 && L != 0) || ph == 2 || ph == 8 || ph == 12 || ph == 13) continue;
            const int tg = g < 2 ? TGM : NTOK - 2 * TGM;
            float* X = ap->out + (size_t)g * TGM * DM;
            unsigned char* wl = ws + WS_W + (size_t)L * WL_SIZE;
            switch (ph) {
            CASE(0) {
                const float* xin = (g < 2) ? ap->in[I_XP] + (size_t)g * TGM * DM : ap->in[I_XS];
                intake_rows(xin, X, (bf16_t*)(ws + WS_H), (float*)(ws + WS_RS), tg, wv);
                const float* psrc = ap->in[I_PP]; (void)psrc; } break;
            CASE(1) {
                pg8::Gemm gm{(const bf16_t*)(ws + WS_H), (const bf16_t*)(wl + WL_CAT), 1024, 1024, 1024}; pg8::StaticOrder S; S.init(tg, 4096, G, lbid());
                pg8::EpiBf16 E{(bf16_t*)(ws + WS_Z), (bf16_t*)(ws + WS_Z), ZC, 1 << 30, (const float*)(ws + WS_RS), (float*)(ws + WS_RSM)}; pg8::gemm_phase(lds, gm, S, E, wv); } break;
            CASE(2) {
                } break;
            CASE(3) {
                const float* rcos = (const float*)(ws + WS_ROPE);
                pg8::Gemm gm{(const bf16_t*)(ws + WS_Z), (const bf16_t*)(wl + WL_MLA), ZC, 512, 512}; pg8::StaticOrder S; S.init(tg, 1024, G, lbid());
                pg8::EpiMla E{(bf16_t*)(ws + WS_QKV), rcos, rcos + SEQ * 16, 0.10206207261596577f * LOG2E, (const float*)(ws + WS_RSM)}; pg8::gemm_phase(lds, gm, S, E, wv); } break;
            CASE(4) {
                if (tg / SEQ >= 4) mla_phase2((const bf16_t*)(ws + WS_QKV), (bf16_t*)(ws + WS_O), lds, tg / SEQ, wv);
                else mla_phase((const bf16_t*)(ws + WS_QKV), (bf16_t*)(ws + WS_O), lds, tg / SEQ, wv);
                small_attn_phase(ap, L, (const bf16_t*)(ws + WS_Z), (bf16_t*)(ws + WS_O), (bf16_t*)(ws + WS_OD), (float*)(ws + WS_LSE), lds, tg, wv); } break;
            CASE(5) {
                pg8::Gemm gm{(const bf16_t*)(ws + WS_H), (const bf16_t*)(wl + WL_CAT) + (size_t)4096 * 1024, 1024, 1024, 1024}; pg8::StaticOrder S; S.init(tg, 4096, G, lbid());
                pg8::EpiBf16 E{(bf16_t*)(ws + WS_G), (bf16_t*)(ws + WS_G), ZC, 0, (const float*)(ws + WS_RS)}; pg8::gemm_phase(lds, gm, S, E, wv);
                for (int r0 = lbid() * 128; r0 < tg; r0 += G * 128) dil_combine((const bf16_t*)(ws + WS_OD), (const float*)(ws + WS_LSE), (bf16_t*)(ws + WS_O), r0, 128, tg, wv); } break;
            CASE(6) {
                branch_phase(lds, (const bf16_t*)(ws + WS_O), (const bf16_t*)(wl + WL_B), (const bf16_t*)(ws + WS_G), (bf16_t*)(ws + WS_MG), tg, wv); } break;
            CASE(7) {
                pg8::Gemm gm{(const bf16_t*)(ws + WS_MG), (const bf16_t*)(wl + WL_OUT), 1024, 1024, 1024}; pg8::StaticOrder S; S.init(tg, 1024, G, lbid());
                pg8::EpiResid E{X, nullptr, nullptr, (bf16_t*)(ws + WS_H), (float*)(ws + WS_RS) + (size_t)TGM * 16}; pg8::gemm_phase(lds, gm, S, E, wv);
                const float* psrc = (g < 2) ? ap->in[I_PP] + ((size_t)L * NPROMPT + (size_t)g * TGM) * 256 : ap->in[I_PS] + (size_t)L * (NTOK - NPROMPT) * 256;
                cvt_p(psrc, (bf16_t*)(ws + WS_PB), tg, wv); } break;
            CASE(8) {
                } break;
            CASE(9) {
                pg8::Gemm gm{(const bf16_t*)(ws + WS_H), (const bf16_t*)(wl + WL_UP), 1024, 1024, 1024}; pg8::StaticOrder S; S.init(tg, DFF2, G, lbid());
                pg8::EpiBf16 E{(bf16_t*)(ws + WS_U), (bf16_t*)(ws + WS_U), DFF2, 1 << 30, (const float*)(ws + WS_RS) + (size_t)TGM * 16}; pg8::gemm_phase(lds, gm, S, E, wv);
                __syncthreads();
                pg8::Gemm gm2{(const bf16_t*)(ws + WS_PB), (const bf16_t*)(wl + WL_PP), 256, 256, 256}; pg8::StaticOrder S2; S2.init(tg, 1024, G, lbid());
                pg8::EpiBf16 E2{(bf16_t*)(ws + WS_PP), (bf16_t*)(ws + WS_PP), 1024, 1 << 30, nullptr}; pg8::gemm_phase(lds, gm2, S2, E2, wv); } break;
            CASE(10) {
                conv_pass((const bf16_t*)(ws + WS_U), ap->in[I_CW] + (size_t)L * 3 * DFF2, ap->in[I_CB] + (size_t)L * DFF2, (bf16_t*)(ws + WS_GA), tg, wv); } break;
            CASE(11) {
                pg8::Gemm gm{(const bf16_t*)(ws + WS_GA), (const bf16_t*)(wl + WL_DOWN), DFF, DFF, DFF}; pg8::StaticOrder S; S.init(tg, 1024, G, lbid());
                pg8::EpiResid E{X, nullptr, nullptr, (bf16_t*)(ws + WS_H1), (float*)(ws + WS_RS) + (size_t)2 * TGM * 16}; pg8::gemm_phase(lds, gm, S, E, wv); } break;
            CASE(12) {
                } break;
            CASE(13) { } break;
            CASE(14) {
                pg8::Gemm gm{(const bf16_t*)(ws + WS_H1), (const bf16_t*)(wl + WL_PG), 1024, 1024, 1024}; pg8::StaticOrder S; S.init(tg, 1024, G, lbid());
                pg8::EpiResid E{X, (const bf16_t*)(ws + WS_PP), (const float*)(ws + WS_RS) + (size_t)2 * TGM * 16, (bf16_t*)(ws + WS_H), (float*)(ws + WS_RS)}; pg8::gemm_phase(lds, gm, S, E, wv); } break;
            CASE(15) {
                final_norm_rows(X, ap->in[I_LNFIN], tg, wv); } break;
            default: break;
            }
        }
        if (s + 1 < s_hi) xcd_barrier((unsigned*)(ap->ws + WS_BAR), bst, ltid(wv));
    }
#undef CASE
}

#ifndef MK_MULTI
#define MK_MULTI 0
#endif
extern "C" void kernel_launch(void* const* d_in, const int* in_sizes, int n_in, void* d_out, int out_size, void* d_ws, size_t ws_size, hipStream_t stream) {
    static int grid = 0;
    if (grid == 0) {
        if (n_in != 25 || out_size != NTOK * DM || ws_size < WS_END) { fprintf(stderr, "kernel_launch: unexpected shapes (n_in %d out %d ws %zu)\n", n_in, out_size, ws_size); grid = -1; return; }
        int dev = 0, cus = 0, per_cu = 0;
        hipGetDevice(&dev); hipDeviceGetAttribute(&cus, hipDeviceAttributeMultiprocessorCount, dev);
        if (hipFuncSetAttribute((const void*)fwd_kernel, hipFuncAttributeMaxDynamicSharedMemorySize, LDS_BYTES) != hipSuccess) { fprintf(stderr, "kernel_launch: hipFuncSetAttribute failed\n"); grid = -1; return; }
        hipOccupancyMaxActiveBlocksPerMultiprocessor(&per_cu, (const void*)fwd_kernel, 512, LDS_BYTES);
        (void)hipGetLastError();
        if (per_cu < 1) { fprintf(stderr, "kernel_launch: occupancy query says %d blocks/CU\n", per_cu); per_cu = 1; }
        grid = cus;
    }
    if (grid < 0) return;
    if (hipMemsetAsync((char*)d_ws + WS_BAR, 0, WS_BAR_BYTES, stream) != hipSuccess) { fprintf(stderr, "kernel_launch: memset failed\n"); return; }
    Args a{};
    for (int i = 0; i < 25; ++i) a.in[i] = (const float*)d_in[i];
    a.out = (float*)d_out; a.ws = (unsigned char*)d_ws;
#if MK_MULTI
    for (int s = 0; s < N_STEPS; ++s) { a.lo = s; a.hi = s + 1; hipLaunchKernelGGL(fwd_kernel, dim3(grid), dim3(512), LDS_BYTES, stream, a); }
#else
    a.lo = 0; a.hi = N_STEPS;
    void* args[] = {&a};
    hipError_t e = hipLaunchCooperativeKernel((const void*)fwd_kernel, dim3(grid), dim3(512), args, LDS_BYTES, stream);
    if (e != hipSuccess) fprintf(stderr, "kernel_launch: cooperative launch failed: %s (grid %d)\n", hipGetErrorString(e), grid);
#endif
}
```

```cpp
#include <hip/hip_runtime.h>
#include <hip/hip_cooperative_groups.h>
#include <cstdio>
#include <cstdint>
namespace cg = cooperative_groups;

#define LAS __attribute__((address_space(3)))
typedef unsigned short bf16_t;
typedef short bf16x8 __attribute__((ext_vector_type(8)));
typedef short s16x4 __attribute__((ext_vector_type(4)));
typedef float f32x2 __attribute__((ext_vector_type(2)));
typedef float f32x4 __attribute__((ext_vector_type(4)));
typedef float f32x16 __attribute__((ext_vector_type(16)));
typedef unsigned u32x2 __attribute__((ext_vector_type(2)));
typedef unsigned u32x4 __attribute__((ext_vector_type(4)));
typedef __bf16 bf16x2_t __attribute__((ext_vector_type(2)));

constexpr int DM = 1024, SEQ = 8192, NTOK = 81920, NPROMPT = 65536, TGM = 32768  , NGROUP = 3, DEPTH = 4;
constexpr int ZC = 4096;
constexpr int DFF = 2816, DFF2 = 5632;
constexpr int COL_B = 416, COL_C = 2720, COL_D = 3232;
constexpr float LOG2E = 1.4426950408889634f;
constexpr float EPS = 1e-6f;
constexpr float NEGBIG = -3.0e38f;

constexpr size_t MiB = 1u << 20;
constexpr size_t WS_ROPE = 0;
constexpr size_t WS_TAB = 1 * MiB;
constexpr size_t WS_BAR = 1 * MiB + 512 * 1024, WS_BAR_BYTES = 16384;
constexpr size_t WS_W = 2 * MiB;
constexpr size_t WL_CAT = 0, WL_MLA = 16 * MiB, WL_B = 17 * MiB, WL_OUT = 19 * MiB, WL_UP = 21 * MiB, WL_DOWN = 32 * MiB,
                 WL_PG = 32 * MiB + 5632 * 1024, WL_PP = WL_PG + 2 * MiB, WL_SIZE = 40 * MiB;
constexpr size_t WS_ACT = 162 * MiB;
constexpr size_t WS_Z = WS_ACT, WS_G = WS_ACT, WS_U = WS_ACT, WS_QKV = WS_ACT + 256 * MiB, WS_O = WS_ACT + 320 * MiB, WS_A2 = WS_O, WS_OD = WS_ACT + 384 * MiB,
                 WS_LSE = WS_ACT + 432 * MiB, WS_MB = WS_ACT + 434 * MiB, WS_MG = WS_ACT + 498 * MiB, WS_GA = WS_ACT + 352 * MiB, WS_PP = WS_ACT + 528 * MiB,
                 WS_PB = WS_ACT + 592 * MiB, WS_H = WS_ACT + 608 * MiB, WS_H1 = WS_ACT + 672 * MiB, WS_RS = WS_ACT + 736 * MiB  , WS_RSM = WS_ACT + 742 * MiB  , WS_END = WS_ACT + 743 * MiB;

__device__ __forceinline__ float bf2f(unsigned short b) { return __builtin_bit_cast(float, (unsigned)b << 16); }
__device__ __forceinline__ unsigned cvtpk(float lo, float hi) { f32x2 v = {lo, hi}; bf16x2_t b = __builtin_convertvector(v, bf16x2_t); return __builtin_bit_cast(unsigned, b); }
__device__ __forceinline__ float shx(float v, int o, int lane) { return __builtin_bit_cast(float, __builtin_amdgcn_ds_bpermute((lane ^ o) << 2, __builtin_bit_cast(int, v))); }
__device__ __forceinline__ void xhalf_swap(float& a, float& b) { asm volatile("s_nop 1\n\tv_permlane32_swap_b32 %0, %1\n\ts_nop 1" : "+v"(a), "+v"(b)); }
__device__ __forceinline__ float xhalf_max(float v) { float a = v, b = v; xhalf_swap(a, b); return fmaxf(a, b); }
__device__ __forceinline__ float xhalf_sum(float v) { float a = v, b = v; xhalf_swap(a, b); return a + b; }
__device__ __forceinline__ float wave_sum(float v, int lane) {
#pragma unroll
    for (int o = 1; o < 64; o <<= 1) v += shx(v, o, lane);
    return v;
}
__device__ __forceinline__ float sigmoidf_(float v) { return __builtin_amdgcn_rcpf(1.0f + __expf(-v)); }
__device__ __forceinline__ float gelu_tanh(float x) { const float u = 0.7978845608028654f * (x + 0.044715f * x * x * x); return x * sigmoidf_(2.0f * u); }
__device__ __forceinline__ void st16_wt(void* p, u32x4 v) { asm volatile("global_store_dwordx4 %0, %1, off sc1\n\ts_nop 2" :: "v"(p), "v"(v) : "memory"); }
__device__ __forceinline__ void st16f_wt(void* p, f32x4 v) { asm volatile("global_store_dwordx4 %0, %1, off sc1\n\ts_nop 2" :: "v"(p), "v"(v) : "memory"); }
__device__ __forceinline__ int crow(int r, int hi) { return (r & 3) + 8 * (r >> 2) + 4 * hi; }
__device__ __forceinline__ int ltid(int wv) { unsigned z = 0u; asm volatile("" : "+v"(z)); return wv * 64 + (int)__builtin_amdgcn_mbcnt_hi(~0u, __builtin_amdgcn_mbcnt_lo(~0u, z)); }
__device__ __forceinline__ int lgrid() { int g = gridDim.x; asm volatile("" : "+s"(g)); return g; }
__device__ __forceinline__ int lbid() { int b = blockIdx.x; asm volatile("" : "+s"(b)); return b; }
__device__ __forceinline__ int clampi(int v, int lo, int hi) { return v < lo ? lo : (v > hi ? hi : v); }

namespace pg8 {
constexpr int BM = 256, BK = 64, HALF = 128, HTB = HALF * BK * 2, STAGE_BYTES = 8 * HTB, NXCD = 8, WGM = 8;
__host__ __device__ __forceinline__ int lds_byte(int r, int c) { const int st = (r >> 4) * 2 + (c >> 5), rr = r & 15, cc = c & 31, ob = rr * 64 + cc * 2; return st * 1024 + (ob ^ (((ob >> 9) & 1) << 5)); }
__host__ __device__ __forceinline__ void stage_rc(int b, int& R, int& C) { const int st = b / 1024, sb = b % 1024, swz = sb ^ (((sb >> 9) & 1) << 5); R = (st >> 1) * 16 + swz / 64; C = (st & 1) * 32 + (swz % 64) / 2; }
__host__ __device__ __forceinline__ int perm32(int rho) { const int n = rho >> 4, i = rho & 15; return 8 * (i >> 2) + 4 * n + (i & 3); }

struct Unit { int pm, pn, ak; };
struct Gemm { const bf16_t* A; const bf16_t* Bt; int lda, ldb, K; };

struct StaticOrder {
    int nM, nN, nwg, G, c;
    __device__ __forceinline__ void init(int M, int N, int G_, int c_) { nM = M / BM; nN = N / BM; nwg = nM * nN; G = G_; c = c_; }
    __device__ __forceinline__ bool next(int i, Unit& u) const {
        const long L = (long)i * G + c; if (L >= nwg) return false;
        int wgid = (int)L; { const int q = nwg / NXCD, r = nwg % NXCD, xcd = wgid % NXCD, off = wgid / NXCD; wgid = (xcd < r ? xcd * (q + 1) : r * (q + 1) + (xcd - r) * q) + off; }
        const int nig = WGM * nN, gid = wgid / nig, fm = gid * WGM, gsz = (nM - fm) < WGM ? (nM - fm) : WGM;
        u.pm = fm + ((wgid % nig) % gsz); u.pn = (wgid % nig) / gsz; u.ak = 0; return true;
    }
};
struct BranchOrder {
    int G, c, ntile;
    __device__ __forceinline__ bool next(int i, Unit& u) const {
        const int L = (i >> 2) * G + c; if (L >= ntile) return false;
        const int j = i & 3; u.pm = L >> 2; u.pn = j * 4 + (L & 3); u.ak = j * 256; return true;
    }
};

#define EPI_LOOP_ROWS for (int ai = 0; ai < 2; ++ai) _Pragma("unroll") for (int m = 0; m < 4; ++m)

__device__ __forceinline__ float row_part(const float* RS, int row, int fq) { const f32x4 a = ((const f32x4*)(RS + (size_t)row * 16))[fq]; return (a.x + a.y) + (a.z + a.w); }
__device__ __forceinline__ float row_rstd_fin(float s, int lane) { s += shx(s, 16, lane); s += shx(s, 32, lane); return rsqrtf(s * (1.0f / 1024.0f) + EPS); }
struct EpiBf16 {
    static constexpr bool PERM = true;
    bf16_t* O0; bf16_t* O1; int ldc; int split_pn; const float* RS; float* RSM;
    __device__ __forceinline__ void operator()(const f32x4 (&acc)[2][2][4][2], const Unit& u, int wv) const {
        const int t_ = ltid(wv), wid_ = __builtin_amdgcn_readfirstlane(t_ >> 6), wr = wid_ >> 2, wc = wid_ & 3, fr = t_ & 15, fq = (t_ & 63) >> 4;
        const bool gate = u.pn >= split_pn;
        bf16_t* base = gate ? O1 : O0;
        const int col0 = (gate ? (u.pn - split_pn) : u.pn) * BM + wc * 32 + 8 * fq;
        const int row0 = u.pm * BM + wr * 64 + fr;
        float rs[2][4];
#pragma unroll
        EPI_LOOP_ROWS rs[ai][m] = RS ? row_part(RS, row0 + ai * HALF + m * 16, fq) : 0.f;
#pragma unroll
        EPI_LOOP_ROWS rs[ai][m] = RS ? row_rstd_fin(rs[ai][m], t_ & 63) : 1.0f;
#pragma unroll
        EPI_LOOP_ROWS { bf16_t* rowp = base + (size_t)(row0 + ai * HALF + m * 16) * ldc + col0;
            const float rstd = rs[ai][m];
            float ssm = 0.f;
#pragma unroll
            for (int bj = 0; bj < 2; ++bj) { f32x4 v0 = acc[ai][bj][m][0] * rstd, v1 = acc[ai][bj][m][1] * rstd;
                if (RSM && (u.pn == 0 || (u.pn == 1 && bj == 0))) ssm += ((v0[0] * v0[0] + v0[1] * v0[1]) + (v0[2] * v0[2] + v0[3] * v0[3])) + ((v1[0] * v1[0] + v1[1] * v1[1]) + (v1[2] * v1[2] + v1[3] * v1[3]));
                if (gate) {
#pragma unroll
                    for (int e = 0; e < 4; ++e) { v0[e] = sigmoidf_(v0[e]); v1[e] = sigmoidf_(v1[e]); } }
                u32x4 w; w.x = cvtpk(v0[0], v0[1]); w.y = cvtpk(v0[2], v0[3]); w.z = cvtpk(v1[0], v1[1]); w.w = cvtpk(v1[2], v1[3]);
                st16_wt(rowp + bj * HALF, w); }
            if (RSM && u.pn < 2) { ssm += shx(ssm, 16, t_ & 63); ssm += shx(ssm, 32, t_ & 63);
                if (fq == 0) RSM[(size_t)(row0 + ai * HALF + m * 16) * 8 + u.pn * 4 + wc] = ssm; } }
    }
};
struct EpiMla {
    static constexpr bool PERM = false;
    bf16_t* O; const float* rcos; const float* rsin; float qscale; const float* RSM;
    __device__ __forceinline__ void operator()(const f32x4 (&acc)[2][2][4][2], const Unit& u, int wv) const {
        const int t_ = ltid(wv), wid_ = __builtin_amdgcn_readfirstlane(t_ >> 6), wr = wid_ >> 2, wc = wid_ & 3, fr = t_ & 15, fq = (t_ & 63) >> 4;
        const int row0 = u.pm * BM + wr * 64 + fr;
        float rq[2][4], rkv[2][4];
#pragma unroll
        EPI_LOOP_ROWS { const f32x4* p_ = (const f32x4*)(RSM + (size_t)(row0 + ai * HALF + m * 16) * 8); const f32x4 a_ = p_[0], b_ = p_[1];
            rq[ai][m] = rsqrtf(((a_.x + a_.y) + (a_.z + a_.w)) * (1.0f / 256.0f) + EPS); rkv[ai][m] = rsqrtf(((b_.x + b_.y) + (b_.z + b_.w)) * (1.0f / 128.0f) + EPS); }
#pragma unroll
        for (int bj = 0; bj < 2; ++bj) {
            const int cg = u.pn * BM + bj * HALF + wc * 32;
            const bool rope = (cg < 768) && ((cg % 96) == 64);
            const int kind = (cg < 384) ? 0 : ((cg < 768 && rope) ? 2 : 1);
#pragma unroll
            EPI_LOOP_ROWS { const int row = row0 + ai * HALF + m * 16; f32x4 v0 = acc[ai][bj][m][0], v1 = acc[ai][bj][m][1];
                const float sc = kind == 0 ? qscale * rq[ai][m] : (kind == 1 ? rkv[ai][m] : 1.0f);
                if (rope) { const int pos = row & (SEQ - 1); const f32x4 c = *(const f32x4*)(rcos + pos * 16 + 4 * fq), s = *(const f32x4*)(rsin + pos * 16 + 4 * fq);
                    const f32x4 a = v0 * c - v1 * s, b = v0 * s + v1 * c; v0 = a; v1 = b; }
                v0 = v0 * sc; v1 = v1 * sc;
                bf16_t* p = O + (size_t)row * 1024 + cg + 4 * fq;
                u32x2 w0, w1; w0.x = cvtpk(v0[0], v0[1]); w0.y = cvtpk(v0[2], v0[3]); w1.x = cvtpk(v1[0], v1[1]); w1.y = cvtpk(v1[2], v1[3]);
                *(u32x2*)p = w0; *(u32x2*)(p + 16) = w1; } }
    }
};
struct EpiBranch {
    static constexpr bool PERM = true;
    const bf16_t* Gt; bf16_t* MB; bf16_t* MG;
    __device__ __forceinline__ void operator()(const f32x4 (&acc)[2][2][4][2], const Unit& u, int wv) const {
        const int t_ = ltid(wv), wid_ = __builtin_amdgcn_readfirstlane(t_ >> 6), wr = wid_ >> 2, wc = wid_ & 3, fr = t_ & 15, fq = (t_ & 63) >> 4;
        const int j = u.pn >> 2, tn = u.pn & 3;
        const int col0 = tn * BM + wc * 32 + 8 * fq, row0 = u.pm * BM + wr * 64 + fr;
#pragma unroll
        EPI_LOOP_ROWS { const int row = row0 + ai * HALF + m * 16;
#pragma unroll
            for (int bj = 0; bj < 2; ++bj) { const int col = col0 + bj * HALF;
                const u32x4 g = *(const u32x4*)(Gt + (unsigned)(row * ZC + j * 1024 + col));
                f32x4 v0 = acc[ai][bj][m][0], v1 = acc[ai][bj][m][1];
                v0[0] *= __builtin_bit_cast(float, g.x << 16); v0[1] *= __builtin_bit_cast(float, g.x & 0xffff0000u);
                v0[2] *= __builtin_bit_cast(float, g.y << 16); v0[3] *= __builtin_bit_cast(float, g.y & 0xffff0000u);
                v1[0] *= __builtin_bit_cast(float, g.z << 16); v1[1] *= __builtin_bit_cast(float, g.z & 0xffff0000u);
                v1[2] *= __builtin_bit_cast(float, g.w << 16); v1[3] *= __builtin_bit_cast(float, g.w & 0xffff0000u);
                bf16_t* mp = MB + (unsigned)(row * 1024 + col);
                if (j > 0) { const u32x4 pm_ = *(const u32x4*)mp;
                    v0[0] += __builtin_bit_cast(float, pm_.x << 16); v0[1] += __builtin_bit_cast(float, pm_.x & 0xffff0000u);
                    v0[2] += __builtin_bit_cast(float, pm_.y << 16); v0[3] += __builtin_bit_cast(float, pm_.y & 0xffff0000u);
                    v1[0] += __builtin_bit_cast(float, pm_.z << 16); v1[1] += __builtin_bit_cast(float, pm_.z & 0xffff0000u);
                    v1[2] += __builtin_bit_cast(float, pm_.w << 16); v1[3] += __builtin_bit_cast(float, pm_.w & 0xffff0000u); }
                if (j < 3) { u32x4 w; w.x = cvtpk(v0[0], v0[1]); w.y = cvtpk(v0[2], v0[3]); w.z = cvtpk(v1[0], v1[1]); w.w = cvtpk(v1[2], v1[3]); *(u32x4*)mp = w; }
                else { u32x4 w; w.x = cvtpk(v0[0], v0[1]); w.y = cvtpk(v0[2], v0[3]); w.z = cvtpk(v1[0], v1[1]); w.w = cvtpk(v1[2], v1[3]); *(u32x4*)(MG + (unsigned)(row * 1024 + col)) = w; } }
            if (m & 1) asm volatile("" ::: "memory"); }
    }
};
struct EpiResid {
    static constexpr bool PERM = true;
    float* X; const bf16_t* PP; const float* RSin; bf16_t* XB; float* RSout;
    __device__ __forceinline__ void operator()(const f32x4 (&acc)[2][2][4][2], const Unit& u, int wv) const {
        const int t_ = ltid(wv), wid_ = __builtin_amdgcn_readfirstlane(t_ >> 6), wr = wid_ >> 2, wc = wid_ & 3, fr = t_ & 15, fq = (t_ & 63) >> 4;
        const int col0 = u.pn * BM + wc * 32 + 8 * fq, row0 = u.pm * BM + wr * 64 + fr;
        float rs[2][4], sq[2][4];
#pragma unroll
        EPI_LOOP_ROWS rs[ai][m] = RSin ? row_part(RSin, row0 + ai * HALF + m * 16, fq) : 0.f;
#pragma unroll
        EPI_LOOP_ROWS rs[ai][m] = RSin ? row_rstd_fin(rs[ai][m], t_ & 63) : 1.0f;
#pragma unroll
        EPI_LOOP_ROWS { const size_t row = (size_t)(row0 + ai * HALF + m * 16);
            const float rstd = rs[ai][m]; float ssq = 0.f;
#pragma unroll
            for (int bj = 0; bj < 2; ++bj) { const int col = col0 + bj * HALF;
                f32x4 v0 = acc[ai][bj][m][0] * rstd, v1 = acc[ai][bj][m][1] * rstd;
                if (PP) { const u32x4 g = *(const u32x4*)(PP + row * 1024 + col);
                    v0[0] = sigmoidf_(v0[0]) * __builtin_bit_cast(float, g.x << 16); v0[1] = sigmoidf_(v0[1]) * __builtin_bit_cast(float, g.x & 0xffff0000u);
                    v0[2] = sigmoidf_(v0[2]) * __builtin_bit_cast(float, g.y << 16); v0[3] = sigmoidf_(v0[3]) * __builtin_bit_cast(float, g.y & 0xffff0000u);
                    v1[0] = sigmoidf_(v1[0]) * __builtin_bit_cast(float, g.z << 16); v1[1] = sigmoidf_(v1[1]) * __builtin_bit_cast(float, g.z & 0xffff0000u);
                    v1[2] = sigmoidf_(v1[2]) * __builtin_bit_cast(float, g.w << 16); v1[3] = sigmoidf_(v1[3]) * __builtin_bit_cast(float, g.w & 0xffff0000u); }
                float* xp = X + row * 1024 + col;
                v0 += *(const f32x4*)xp; v1 += *(const f32x4*)(xp + 4);
                *(f32x4*)xp = v0; *(f32x4*)(xp + 4) = v1;
                u32x4 w; w.x = cvtpk(v0[0], v0[1]); w.y = cvtpk(v0[2], v0[3]); w.z = cvtpk(v1[0], v1[1]); w.w = cvtpk(v1[2], v1[3]);
                *(u32x4*)(XB + row * 1024 + col) = w;
                ssq += ((v0[0] * v0[0] + v0[1] * v0[1]) + (v0[2] * v0[2] + v0[3] * v0[3])) + ((v1[0] * v1[0] + v1[1] * v1[1]) + (v1[2] * v1[2] + v1[3] * v1[3])); }
            sq[ai][m] = ssq;
            if (m & 1) asm volatile("" ::: "memory"); }
#pragma unroll
        EPI_LOOP_ROWS sq[ai][m] += shx(sq[ai][m], 16, t_ & 63);
#pragma unroll
        EPI_LOOP_ROWS sq[ai][m] += shx(sq[ai][m], 32, t_ & 63);
        if (fq == 0) {
#pragma unroll
            EPI_LOOP_ROWS RSout[(size_t)(row0 + ai * HALF + m * 16) * 16 + u.pn * 4 + wc] = sq[ai][m]; }
    }
};

template <class Epi, class Sched>
__device__ __forceinline__ void gemm_phase(LAS unsigned char* lds, const Gemm g, const Sched& S, const Epi& E, int wv) {
    int tid = ltid(wv);
    const int wid = __builtin_amdgcn_readfirstlane(tid >> 6), lane = tid & 63, wr = wid >> 2, wc = wid & 3, fr = lane & 15, fq = lane >> 4;
    const int K = g.K, nt = K / BK;
    unsigned voffA[2], voffB[2];
#pragma unroll
    for (int i = 0; i < 2; ++i) { int R, C; stage_rc(tid * 16 + i * 8192, R, C); const int Rb = Epi::PERM ? ((R & ~31) + perm32(R & 31)) : R;
        voffA[i] = (unsigned)(R * g.lda + C) * 2u; voffB[i] = (unsigned)(Rb * g.ldb + C) * 2u; }
    const size_t kstep = (size_t)(BK * 2);
    const size_t hstepA = (size_t)HALF * g.lda * 2, hstepB = (size_t)HALF * g.ldb * 2;
    const size_t tstepA = 2 * hstepA, tstepB = 2 * hstepB;
    const unsigned ldsw = (unsigned)wid * 1024u;
    const int aoff = lds_byte(wr * 64 + fr, fq * 8), boff = lds_byte(wc * 32 + fr, fq * 8);
#define PG8_SA(b, h) (((b) * 2 + (h)) * HTB)
#define PG8_SB(b, h) ((4 + (b) * 2 + (h)) * HTB)
#define PG8_STAGE(bufoff, gbase, voff) do { _Pragma("unroll") for (int _i = 0; _i < 2; ++_i) \
        __builtin_amdgcn_global_load_lds((const unsigned*)((const char*)(gbase) + (voff)[_i]), (LAS unsigned*)(lds + (bufoff) + ldsw + _i * 8192), 16, 0, 0); } while (0)
#define PG8_LDA(dst, b, h) do { _Pragma("unroll") for (int m = 0; m < 4; ++m) _Pragma("unroll") for (int k = 0; k < 2; ++k) dst[m][k] = *(const LAS bf16x8*)(lds + PG8_SA(b, h) + aoff + m * 2048 + k * 1024); } while (0)
#define PG8_LDB(dst, b, h) do { _Pragma("unroll") for (int n = 0; n < 2; ++n) _Pragma("unroll") for (int k = 0; k < 2; ++k) dst[n][k] = *(const LAS bf16x8*)(lds + PG8_SB(b, h) + boff + n * 2048 + k * 1024); } while (0)
#define PG8_MMA(ai, bj, At, Bt) do { __builtin_amdgcn_s_setprio(1); _Pragma("unroll") for (int m = 0; m < 4; ++m) _Pragma("unroll") for (int n = 0; n < 2; ++n) _Pragma("unroll") for (int k = 0; k < 2; ++k) \
        acc[ai][bj][m][n] = __builtin_amdgcn_mfma_f32_16x16x32_bf16(Bt[n][k], At[m][k], acc[ai][bj][m][n], 0, 0, 0); __builtin_amdgcn_s_setprio(0); } while (0)
#define PG8_WAIT_V(n) asm volatile("s_waitcnt vmcnt(" #n ")" ::: "memory")
#define PG8_WAIT_L(n) asm volatile("s_waitcnt lgkmcnt(" #n ")" ::: "memory")
#define PG8_BAR __builtin_amdgcn_s_barrier()
#define PG8_SCHED __builtin_amdgcn_sched_barrier(0)
    Unit cur, nxt; int ui = 0;
    if (!S.next(0, cur)) return;
    f32x4 acc[2][2][4][2];
#pragma unroll
    for (int a = 0; a < 2; ++a)
#pragma unroll
        for (int b = 0; b < 2; ++b)
#pragma unroll
            for (int m = 0; m < 4; ++m)
#pragma unroll
                for (int n = 0; n < 2; ++n) acc[a][b][m][n] = (f32x4){0.f, 0.f, 0.f, 0.f};
    bf16x8 At[4][2], B0[2][2], B1[2][2];
    const char* cA = (const char*)g.A + (size_t)cur.pm * tstepA + (size_t)cur.ak * 2; const char* cB = (const char*)g.Bt + (size_t)cur.pn * tstepB;
    PG8_STAGE(PG8_SB(0, 0), cB, voffB); PG8_STAGE(PG8_SB(0, 1), cB + hstepB, voffB); PG8_STAGE(PG8_SA(0, 0), cA, voffA); PG8_STAGE(PG8_SA(0, 1), cA + hstepA, voffA);
    if (wr == 1) PG8_BAR;
    PG8_WAIT_V(2); PG8_BAR;
    PG8_STAGE(PG8_SB(1, 0), cB + kstep, voffB); PG8_STAGE(PG8_SA(1, 0), cA + kstep, voffA); PG8_STAGE(PG8_SB(1, 1), cB + hstepB + kstep, voffB);
    PG8_WAIT_V(6); PG8_BAR;
    for (;;) {
        const bool has_next = S.next(ui + 1, nxt);
        const char* nA = has_next ? (const char*)g.A + (size_t)nxt.pm * tstepA + (size_t)nxt.ak * 2 : cA; const char* nB = has_next ? (const char*)g.Bt + (size_t)nxt.pn * tstepB : cB;
        for (int t = 0; t < nt; t += 2) {
            const bool last = (t == nt - 2);
            const char* a1 = cA + (size_t)(t + 1) * kstep;
            const char* a2 = last ? nA : cA + (size_t)(t + 2) * kstep; const char* b2 = last ? nB : cB + (size_t)(t + 2) * kstep;
            const char* a3 = a2 + kstep; const char* b3 = b2 + kstep;
            PG8_LDB(B0, 0, 0); PG8_LDB(B1, 0, 1); PG8_SCHED; PG8_LDA(At, 0, 0); PG8_STAGE(PG8_SA(1, 1), a1 + hstepA, voffA);
            PG8_WAIT_V(8); PG8_WAIT_L(0); PG8_BAR; PG8_MMA(0, 0, At, B0); PG8_MMA(0, 1, At, B1); PG8_BAR; PG8_SCHED;
            PG8_LDA(At, 0, 1); PG8_STAGE(PG8_SB(0, 0), b2, voffB); PG8_STAGE(PG8_SB(0, 1), b2 + hstepB, voffB); PG8_STAGE(PG8_SA(0, 0), a2, voffA);
            PG8_WAIT_V(8); PG8_WAIT_L(0); PG8_BAR; PG8_MMA(1, 0, At, B0); PG8_MMA(1, 1, At, B1); PG8_BAR; PG8_SCHED;
            PG8_LDB(B0, 1, 0); PG8_LDB(B1, 1, 1); PG8_SCHED; PG8_LDA(At, 1, 0); PG8_STAGE(PG8_SA(0, 1), a2 + hstepA, voffA);
            PG8_WAIT_V(8); PG8_WAIT_L(0); PG8_BAR; PG8_MMA(0, 0, At, B0); PG8_MMA(0, 1, At, B1); PG8_BAR; PG8_SCHED;
            PG8_LDA(At, 1, 1); PG8_STAGE(PG8_SB(1, 0), b3, voffB); PG8_STAGE(PG8_SB(1, 1), b3 + hstepB, voffB); PG8_STAGE(PG8_SA(1, 0), a3, voffA);
            PG8_WAIT_V(8); PG8_WAIT_L(0); PG8_BAR; PG8_MMA(1, 0, At, B0); PG8_MMA(1, 1, At, B1); PG8_BAR; PG8_SCHED;
        }
        if (wr == 0) PG8_BAR;
        E(acc, cur, wv);
        if (!has_next) break;
#pragma unroll
        for (int a = 0; a < 2; ++a)
#pragma unroll
            for (int b = 0; b < 2; ++b)
#pragma unroll
                for (int m = 0; m < 4; ++m)
#pragma unroll
                    for (int n = 0; n < 2; ++n) acc[a][b][m][n] = (f32x4){0.f, 0.f, 0.f, 0.f};
        cur = nxt; cA = nA; cB = nB; ++ui;
        if (wr == 1) PG8_BAR;
    }
    PG8_WAIT_V(0);
    PG8_BAR;
#undef PG8_SA
#undef PG8_SB
#undef PG8_STAGE
#undef PG8_LDA
#undef PG8_LDB
#undef PG8_MMA
#undef PG8_WAIT_V
#undef PG8_WAIT_L
#undef PG8_BAR
#undef PG8_SCHED
}
}

struct Args { const float* in[25]; float* out; unsigned char* ws; int lo, hi; };
typedef const __attribute__((address_space(4))) Args* ArgP;
enum { I_XP = 0, I_XS, I_PP, I_PS, I_LNA, I_WIN, I_QN, I_KVN, I_WQUP, I_WKVUP, I_SINK, I_RPB, I_REL, I_WGATE, I_WBR, I_WOUT, I_LNF, I_WUP, I_CW, I_CB, I_WDOWN, I_LNP, I_WPG, I_WPP, I_LNFIN };

__device__ __forceinline__ void transpose_item(const float* W, const float* gain, int N, bf16_t* WT, int ldo, int row_off, LAS float* scr, int item, int lane) {
    const int nblk = N / 32, kb = item / nblk, nb = item % nblk, k0 = 64 * kb, n0 = 32 * nb;
#pragma unroll 8
    for (int i = 0; i < 32; ++i) { const int kk = 2 * i + (lane >> 5); scr[kk * 33 + (lane & 31)] = W[(size_t)(k0 + kk) * N + n0 + (lane & 31)]; }
    asm volatile("s_waitcnt lgkmcnt(0)" ::: "memory");
    const int c = lane & 7;
    f32x4 g0 = {1.f, 1.f, 1.f, 1.f}, g1 = g0;
    if (gain) { g0 = *(const f32x4*)(gain + k0 + 8 * c); g1 = *(const f32x4*)(gain + k0 + 8 * c + 4); }
#pragma unroll
    for (int j = 0; j < 4; ++j) { const int n = (lane >> 3) + 8 * j; const LAS float* s = scr + (8 * c) * 33 + n;
        u32x4 o; o.x = cvtpk(s[0 * 33] * g0.x, s[1 * 33] * g0.y); o.y = cvtpk(s[2 * 33] * g0.z, s[3 * 33] * g0.w); o.z = cvtpk(s[4 * 33] * g1.x, s[5 * 33] * g1.y); o.w = cvtpk(s[6 * 33] * g1.z, s[7 * 33] * g1.w);
        *(u32x4*)(WT + (size_t)(row_off + n0 + n) * ldo + k0 + 8 * c) = o; }
    asm volatile("s_waitcnt lgkmcnt(0)" ::: "memory");
}
__device__ __forceinline__ void cvt_matrix(const float* W, const float* gain, int K, int N, bf16_t* WT, int ldo, int row_off, LAS float* scr, int gw, int NGW, int lane, int& base) {
    const int nitems = (K / 64) * (N / 32);
    for (int it = (gw - base % NGW + NGW) % NGW; it < nitems; it += NGW) transpose_item(W, gain, N, WT, ldo, row_off, scr, it, lane);
    base += nitems;
}
__device__ __forceinline__ int t5_bucket(int rel) {
    const int ret = rel > 0 ? 16 : 0; const int n = rel < 0 ? -rel : rel;
    const float nf = (float)(n > 1 ? n : 1);
    int large = 8 + (int)(logf(nf / 8.0f) / 4.852030263919617f * 8.0f);
    large = large < 15 ? large : 15;
    return ret + (n < 8 ? n : large);
}
__device__ __forceinline__ void prologue(ArgP ap, LAS unsigned char* lds, int wv) {
    const int tid = ltid(wv), lane = tid & 63, wave = tid >> 6, G = lgrid(), bid = lbid();
    const int gw = bid * 8 + wave, NGW = G * 8;
    const int gt = bid * 512 + tid, NGT = G * 512;
    LAS float* scr = (LAS float*)(lds + wave * 16384);
    unsigned char* ws = ap->ws;
    int cbase = 0;
    for (int L = 0; L < DEPTH; ++L) {
        unsigned char* wl = ws + WS_W + (size_t)L * WL_SIZE;
        bf16_t* cat = (bf16_t*)(wl + WL_CAT);
        cvt_matrix(ap->in[I_WIN] + (size_t)L * 1024 * 4000, ap->in[I_LNA] + L * DM, 1024, 4000, cat, 1024, 0, scr, gw, NGW, lane, cbase);
        for (int i = gt; i < 96 * 1024 / 8; i += NGT) ((u32x4*)(cat + 4000 * 1024))[i] = (u32x4){0u, 0u, 0u, 0u};
        for (int j = 0; j < 4; ++j) cvt_matrix(ap->in[I_WGATE] + ((size_t)L * 4 + j) * 1024 * 1024, ap->in[I_LNA] + L * DM, 1024, 1024, cat, 1024, 4096 + j * 1024, scr, gw, NGW, lane, cbase);
        for (int j = 0; j < 4; ++j) cvt_matrix(ap->in[I_WBR] + ((size_t)L * 4 + j) * 256 * 1024, nullptr, 256, 1024, (bf16_t*)(wl + WL_B), 256, j * 1024, scr, gw, NGW, lane, cbase);
        cvt_matrix(ap->in[I_WOUT] + (size_t)L * 1024 * 1024, nullptr, 1024, 1024, (bf16_t*)(wl + WL_OUT), 1024, 0, scr, gw, NGW, lane, cbase);
        cvt_matrix(ap->in[I_WUP] + (size_t)L * 1024 * DFF2, ap->in[I_LNF] + L * DM, 1024, DFF2, (bf16_t*)(wl + WL_UP), 1024, 0, scr, gw, NGW, lane, cbase);
        cvt_matrix(ap->in[I_WDOWN] + (size_t)L * DFF * 1024, nullptr, DFF, 1024, (bf16_t*)(wl + WL_DOWN), DFF, 0, scr, gw, NGW, lane, cbase);
        cvt_matrix(ap->in[I_WPG] + (size_t)L * 1024 * 1024, ap->in[I_LNP] + L * DM, 1024, 1024, (bf16_t*)(wl + WL_PG), 1024, 0, scr, gw, NGW, lane, cbase);
        cvt_matrix(ap->in[I_WPP] + (size_t)L * 256 * 1024, nullptr, 256, 1024, (bf16_t*)(wl + WL_PP), 256, 0, scr, gw, NGW, lane, cbase);
        bf16_t* wm = (bf16_t*)(wl + WL_MLA);
        const float* wq = ap->in[I_WQUP] + (size_t)L * 256 * 384; const float* wkv = ap->in[I_WKVUP] + (size_t)L * 128 * 512;
        const float* gqn = ap->in[I_QN] + L * 256; const float* gkvn = ap->in[I_KVN] + L * 128;
        for (int i = gt; i < 1024 * 512; i += NGT) {
            const int n = i >> 9, k = i & 511; float v = 0.f;
            if (n < 384) { if (k < 256) v = wq[k * 384 + n] * gqn[k]; }
            else if (n < 768) { const int n2 = n - 384, h = n2 / 96, d = n2 % 96;
                if (d < 64) { if (k >= 256 && k < 384) v = wkv[(k - 256) * 512 + h * 128 + d] * gkvn[k - 256]; }
                else { if (k == 384 + (d - 64)) v = 1.0f; } }
            else { const int n2 = n - 768, h = n2 >> 6, d = n2 & 63; if (k >= 256 && k < 384) v = wkv[(k - 256) * 512 + h * 128 + 64 + d] * gkvn[k - 256]; }
            wm[i] = (bf16_t)(cvtpk(v, 0.f) & 0xffffu);
        }
    }
    float* rc = (float*)(ws + WS_ROPE); float* rs = rc + SEQ * 16;
    for (int i = gt; i < SEQ * 16; i += NGT) {
        const int pos = i >> 4, f = i & 15;
        const float inv = powf(10000.0f, -(float)(2 * f) / 32.0f);
        const float ang = (float)pos * inv;
        const double rev = (double)ang * 0.15915494309189535; const double fr = rev - floor(rev);
        rc[i] = __builtin_amdgcn_cosf((float)fr); rs[i] = __builtin_amdgcn_sinf((float)fr);
    }
    float* tswa = (float*)(ws + WS_TAB); float* tdil = tswa + 4 * 257;
    const float* rel = ap->in[I_REL];
    for (int i = gt; i < 4 * 257; i += NGT) { const int h = i / 257, off = i % 257 - 128; tswa[i] = rel[t5_bucket(off) * 16 + 12 + h] * LOG2E; }
    for (int i = gt; i < 12 * 129; i += NGT) { const int hh = i / 129, d = i % 129 - 64, gi = hh >> 2; const int dil = gi == 0 ? 1 : (gi == 1 ? 4 : 16);
        tdil[i] = rel[t5_bucket(d * dil) * 16 + hh] * LOG2E; }
}

__device__ __forceinline__ void intake_rows(const float* src, float* copy_dst, bf16_t* dst, float* RS, int nrows, int wv) {
    const int tid_ = ltid(wv); const int lane = tid_ & 63, gw = lbid() * 8 + (tid_ >> 6), NGW = lgrid() * 8;
    for (int m = gw; m < nrows; m += NGW) {
        const f32x4* xr = (const f32x4*)(src + (size_t)m * DM) + lane;
        f32x4 v[4]; float s = 0.f;
#pragma unroll
        for (int j = 0; j < 4; ++j) { v[j] = xr[64 * j]; s += (v[j].x * v[j].x + v[j].y * v[j].y) + (v[j].z * v[j].z + v[j].w * v[j].w); }
        s = wave_sum(s, lane);
        f32x4* cr = (f32x4*)(copy_dst + (size_t)m * DM) + lane;
#pragma unroll
        for (int j = 0; j < 4; ++j) cr[64 * j] = v[j];
        u32x2* o8 = (u32x2*)(dst + (size_t)m * DM) + lane;
#pragma unroll
        for (int j = 0; j < 4; ++j) { u32x2 w; w.x = cvtpk(v[j].x, v[j].y); w.y = cvtpk(v[j].z, v[j].w); o8[64 * j] = w; }
        if (lane < 16) RS[(size_t)m * 16 + lane] = lane == 0 ? s : 0.f;
    }
}
__device__ __forceinline__ void norm_rows(const float* src, float* copy_dst, const float* gain, bf16_t* dst, int nrows, int wv) {
    const int tid_ = ltid(wv); const int lane = tid_ & 63, gw = lbid() * 8 + (tid_ >> 6), NGW = lgrid() * 8;
    f32x4 gn[4];
#pragma unroll
    for (int j = 0; j < 4; ++j) gn[j] = ((const f32x4*)gain)[lane + 64 * j];
    for (int m = gw; m < nrows; m += NGW) {
        const f32x4* xr = (const f32x4*)(src + (size_t)m * DM) + lane;
        f32x4 v[4]; float s = 0.f;
#pragma unroll
        for (int j = 0; j < 4; ++j) { v[j] = xr[64 * j]; s += (v[j].x * v[j].x + v[j].y * v[j].y) + (v[j].z * v[j].z + v[j].w * v[j].w); }
        const float rstd = rsqrtf(wave_sum(s, lane) * (1.f / DM) + EPS);
        if (copy_dst) { f32x4* cr = (f32x4*)(copy_dst + (size_t)m * DM) + lane;
#pragma unroll
            for (int j = 0; j < 4; ++j) cr[64 * j] = v[j]; }
        u32x2* o8 = (u32x2*)(dst + (size_t)m * DM) + lane;
#pragma unroll
        for (int j = 0; j < 4; ++j) { const f32x4 y = v[j] * rstd * gn[j]; u32x2 w; w.x = cvtpk(y.x, y.y); w.y = cvtpk(y.z, y.w); o8[64 * j] = w; }
    }
}
__device__ __forceinline__ void final_norm_rows(float* x, const float* gain, int nrows, int wv) {
    const int tid_ = ltid(wv); const int lane = tid_ & 63, gw = lbid() * 8 + (tid_ >> 6), NGW = lgrid() * 8;
    f32x4 gn[4];
#pragma unroll
    for (int j = 0; j < 4; ++j) gn[j] = ((const f32x4*)gain)[lane + 64 * j];
    for (int m = gw; m < nrows; m += NGW) {
        f32x4* xr = (f32x4*)(x + (size_t)m * DM) + lane;
        f32x4 v[4]; float s = 0.f;
#pragma unroll
        for (int j = 0; j < 4; ++j) { v[j] = xr[64 * j]; s += (v[j].x * v[j].x + v[j].y * v[j].y) + (v[j].z * v[j].z + v[j].w * v[j].w); }
        const float rstd = rsqrtf(wave_sum(s, lane) * (1.f / DM) + EPS);
#pragma unroll
        for (int j = 0; j < 4; ++j) xr[64 * j] = v[j] * rstd * gn[j];
    }
}
__device__ __forceinline__ void mla_prep(const bf16_t* __restrict__ Z, const float* __restrict__ qn, const float* __restrict__ kvn, bf16_t* __restrict__ A2, int r0, int wv) {
    const int tid_ = ltid(wv); const int lane = tid_ & 63;
    const f32x4 gq = ((const f32x4*)qn)[lane]; const f32x2 gk = ((const f32x2*)kvn)[lane];
#pragma unroll 8
    for (int t = r0 + wv * 32; t < r0 + wv * 32 + 32; ++t) {
        const bf16_t* z = Z + (size_t)t * ZC;
        const u32x2 a = *(const u32x2*)(z + 4 * lane);
        const unsigned b = *(const unsigned*)(z + 256 + 2 * lane);
        const unsigned short c = lane < 32 ? z[384 + lane] : (unsigned short)0;
        const float a0 = __builtin_bit_cast(float, a.x << 16), a1 = __builtin_bit_cast(float, a.x & 0xffff0000u), a2 = __builtin_bit_cast(float, a.y << 16), a3 = __builtin_bit_cast(float, a.y & 0xffff0000u);
        const float b0 = __builtin_bit_cast(float, b << 16), b1 = __builtin_bit_cast(float, b & 0xffff0000u);
        const float rq = rsqrtf(wave_sum(a0 * a0 + a1 * a1 + a2 * a2 + a3 * a3, lane) * (1.f / 256.f) + EPS);
        const float rk = rsqrtf(wave_sum(b0 * b0 + b1 * b1, lane) * (1.f / 128.f) + EPS);
        bf16_t* o = A2 + (size_t)t * 512;
        u32x2 w; w.x = cvtpk(a0 * rq * gq.x, a1 * rq * gq.y); w.y = cvtpk(a2 * rq * gq.z, a3 * rq * gq.w);
        *(u32x2*)(o + 4 * lane) = w;
        *(unsigned*)(o + 256 + 2 * lane) = cvtpk(b0 * rk * gk.x, b1 * rk * gk.y);
        o[384 + lane] = c;
        o[448 + lane] = 0;
    }
}
__device__ __forceinline__ float bfe(const u32x4& w, int e) { return (e & 1) ? __builtin_bit_cast(float, w[e >> 1] & 0xffff0000u) : __builtin_bit_cast(float, w[e >> 1] << 16); }
__device__ __forceinline__ void conv_pass(const bf16_t* __restrict__ U, const float* __restrict__ cw, const float* __restrict__ cb, bf16_t* __restrict__ GA, int tg, int wv) {
    const int gt = lbid() * 512 + ltid(wv), NGT = lgrid() * 512;
    constexpr int NCH = DFF / 8, RUN = 8; const int NITEM = (tg / RUN) * NCH;
    for (int it = gt; it < NITEM; it += NGT) {
        const int ch = it % NCH, run = it / NCH, c0 = ch * 8, t0 = run * RUN;
        const u32x4 zero = {0u, 0u, 0u, 0u};
        u32x4 ra[RUN + 2], rb[RUN + 2];
#pragma unroll
        for (int i = 0; i < RUN + 2; ++i) {
            const int t = t0 - 1 + i;
            const bool ok = !((i == 0 && (t0 & (SEQ - 1)) == 0) || (i == RUN + 1 && ((t0 + RUN) & (SEQ - 1)) == 0));
            const bf16_t* p = U + (size_t)(ok ? t : t0) * DFF2 + c0;
            const u32x4 a = *(const u32x4*)p, b = *(const u32x4*)(p + DFF);
            ra[i] = ok ? a : zero; rb[i] = ok ? b : zero;
        }
        f32x4 wa[3][2], wb[3][2], ba[2], bb[2];
#pragma unroll
        for (int k = 0; k < 3; ++k) { wa[k][0] = *(const f32x4*)(cw + k * DFF2 + c0); wa[k][1] = *(const f32x4*)(cw + k * DFF2 + c0 + 4);
                                      wb[k][0] = *(const f32x4*)(cw + k * DFF2 + DFF + c0); wb[k][1] = *(const f32x4*)(cw + k * DFF2 + DFF + c0 + 4); }
        ba[0] = *(const f32x4*)(cb + c0); ba[1] = *(const f32x4*)(cb + c0 + 4); bb[0] = *(const f32x4*)(cb + DFF + c0); bb[1] = *(const f32x4*)(cb + DFF + c0 + 4);
#pragma unroll
        for (int i = 0; i < RUN; ++i) {
            float o[8];
#pragma unroll
            for (int e = 0; e < 8; ++e) {
                const float ua = bfe(ra[i], e) * wa[0][e >> 2][e & 3] + bfe(ra[i + 1], e) * wa[1][e >> 2][e & 3] + bfe(ra[i + 2], e) * wa[2][e >> 2][e & 3] + ba[e >> 2][e & 3];
                const float ub = bfe(rb[i], e) * wb[0][e >> 2][e & 3] + bfe(rb[i + 1], e) * wb[1][e >> 2][e & 3] + bfe(rb[i + 2], e) * wb[2][e >> 2][e & 3] + bb[e >> 2][e & 3];
                o[e] = gelu_tanh(ua) * ub;
            }
            u32x4 w; w.x = cvtpk(o[0], o[1]); w.y = cvtpk(o[2], o[3]); w.z = cvtpk(o[4], o[5]); w.w = cvtpk(o[6], o[7]);
            st16_wt(GA + (size_t)(t0 + i) * DFF + c0, w);
        }
    }
}
__device__ __forceinline__ void cvt_p(const float* P, bf16_t* PB, int tg, int wv) {
    const int gt = lbid() * 512 + ltid(wv), NGT = lgrid() * 512;
    for (int i = gt; i < tg * 256 / 8; i += NGT) { const f32x4 a = ((const f32x4*)P)[2 * i], b = ((const f32x4*)P)[2 * i + 1];
        u32x4 w; w.x = cvtpk(a.x, a.y); w.y = cvtpk(a.z, a.w); w.z = cvtpk(b.x, b.y); w.w = cvtpk(b.z, b.w); ((u32x4*)PB)[i] = w; }
}
__device__ __forceinline__ void dil_combine(const bf16_t* __restrict__ OD, const float* __restrict__ LSE, bf16_t* __restrict__ O, int r0, int nrows, int tg, int wv) {
    const int tid = ltid(wv);
#pragma unroll 8
    for (int i = tid; i < nrows * 32; i += 512) {
        const int t = r0 + (i >> 5), c8 = i & 31, slot = c8 >> 3;
        const float l0 = LSE[(size_t)t * 4 + slot], l1 = LSE[(size_t)(tg + t) * 4 + slot], l2 = LSE[(size_t)(2 * tg + t) * 4 + slot];
        const float mx = fmaxf(l0, fmaxf(l1, l2));
        float w0 = __builtin_amdgcn_exp2f(l0 - mx), w1 = __builtin_amdgcn_exp2f(l1 - mx), w2 = __builtin_amdgcn_exp2f(l2 - mx);
        const float inv = 1.0f / (w0 + w1 + w2); w0 *= inv; w1 *= inv; w2 *= inv;
        const u32x4 a = *(const u32x4*)(OD + (size_t)t * 256 + c8 * 8), b = *(const u32x4*)(OD + (size_t)(tg + t) * 256 + c8 * 8), c = *(const u32x4*)(OD + (size_t)(2 * tg + t) * 256 + c8 * 8);
        u32x4 w;
#pragma unroll
        for (int e = 0; e < 4; ++e) {
            const float lo = w0 * __builtin_bit_cast(float, a[e] << 16) + w1 * __builtin_bit_cast(float, b[e] << 16) + w2 * __builtin_bit_cast(float, c[e] << 16);
            const float hi = w0 * __builtin_bit_cast(float, a[e] & 0xffff0000u) + w1 * __builtin_bit_cast(float, b[e] & 0xffff0000u) + w2 * __builtin_bit_cast(float, c[e] & 0xffff0000u);
            w[e] = cvtpk(lo, hi);
        }
        *(u32x4*)(O + (size_t)t * 1024 + 256 + c8 * 8) = w;
    }
}

struct WaveAttn { f32x16 o0, o1; float m, l; };
__device__ __forceinline__ void wa_init(WaveAttn& st) {
#pragma unroll
    for (int r = 0; r < 16; ++r) { st.o0[r] = 0.f; st.o1[r] = 0.f; }
    st.m = -1.0e30f; st.l = 0.f;
}
__device__ __forceinline__ s16x4 vtr(LAS const unsigned char* p) { return __builtin_bit_cast(s16x4, __builtin_amdgcn_ds_read_tr16_b64_v4i16((LAS s16x4*)p)); }
__device__ __forceinline__ void softmax_pv(WaveAttn& st, f32x16 s, LAS const unsigned char* vb, int lane) {
    float mx = s[0];
#pragma unroll
    for (int r = 1; r < 16; ++r) mx = fmaxf(mx, s[r]);
    mx = xhalf_max(mx);
    if (__builtin_amdgcn_ballot_w64(mx > st.m + 8.0f) != 0ull) {
        const float mn = fmaxf(st.m, mx);
        const float alpha = __builtin_amdgcn_exp2f(st.m - mn);
        st.m = mn; st.l *= alpha;
#pragma unroll
        for (int r = 0; r < 16; ++r) { st.o0[r] *= alpha; st.o1[r] *= alpha; }
    }
    const float mn = st.m;
    float ps = 0.f;
#pragma unroll
    for (int r = 0; r < 16; ++r) { s[r] = __builtin_amdgcn_exp2f(s[r] - mn); ps += s[r]; }
    st.l += ps;
    u32x4 p0, p1;
    p0.x = cvtpk(s[0], s[1]); p0.y = cvtpk(s[2], s[3]); p0.z = cvtpk(s[4], s[5]); p0.w = cvtpk(s[6], s[7]);
    p1.x = cvtpk(s[8], s[9]); p1.y = cvtpk(s[10], s[11]); p1.z = cvtpk(s[12], s[13]); p1.w = cvtpk(s[14], s[15]);
    const bf16x8 pb0 = __builtin_bit_cast(bf16x8, p0), pb1 = __builtin_bit_cast(bf16x8, p1);
#define VFRAG(off) ({ const s16x4 lo_ = vtr(vb + (off)); const s16x4 hi_ = vtr(vb + (off) + 512); (bf16x8){lo_[0], lo_[1], lo_[2], lo_[3], hi_[0], hi_[1], hi_[2], hi_[3]}; })
    { const bf16x8 v00 = VFRAG(0), v01 = VFRAG(1024), v10 = VFRAG(2048), v11 = VFRAG(2048 + 1024);
      st.o0 = __builtin_amdgcn_mfma_f32_32x32x16_bf16(v00, pb0, st.o0, 0, 0, 0);
      st.o0 = __builtin_amdgcn_mfma_f32_32x32x16_bf16(v01, pb1, st.o0, 0, 0, 0);
      st.o1 = __builtin_amdgcn_mfma_f32_32x32x16_bf16(v10, pb0, st.o1, 0, 0, 0);
      st.o1 = __builtin_amdgcn_mfma_f32_32x32x16_bf16(v11, pb1, st.o1, 0, 0, 0); }
#undef VFRAG
}
__device__ __forceinline__ void xhalf_swap_u(unsigned& a, unsigned& b) { asm volatile("s_nop 1\n\tv_permlane32_swap_b32 %0, %1\n\ts_nop 1" : "+v"(a), "+v"(b)); }
__device__ __forceinline__ void store_o(const WaveAttn& st, float l_tot, bf16_t* orow, int hi) {
    const float inv = 1.0f / l_tot;
#pragma unroll
    for (int p = 0; p < 2; ++p) {
        const int g0 = 2 * p, g1 = 2 * p + 1;
        unsigned ax = cvtpk(st.o0[4 * g0] * inv, st.o0[4 * g0 + 1] * inv), ay = cvtpk(st.o0[4 * g0 + 2] * inv, st.o0[4 * g0 + 3] * inv);
        unsigned bx = cvtpk(st.o0[4 * g1] * inv, st.o0[4 * g1 + 1] * inv), by = cvtpk(st.o0[4 * g1 + 2] * inv, st.o0[4 * g1 + 3] * inv);
        xhalf_swap_u(ax, bx); xhalf_swap_u(ay, by);
        *(u32x4*)(orow + 8 * (g0 + hi)) = (u32x4){ax, ay, bx, by};
        unsigned cx = cvtpk(st.o1[4 * g0] * inv, st.o1[4 * g0 + 1] * inv), cy = cvtpk(st.o1[4 * g0 + 2] * inv, st.o1[4 * g0 + 3] * inv);
        unsigned dx = cvtpk(st.o1[4 * g1] * inv, st.o1[4 * g1 + 1] * inv), dy = cvtpk(st.o1[4 * g1 + 2] * inv, st.o1[4 * g1 + 3] * inv);
        xhalf_swap_u(cx, dx); xhalf_swap_u(cy, dy);
        *(u32x4*)(orow + 32 + 8 * (g0 + hi)) = (u32x4){cx, cy, dx, dy};
    }
}
__device__ __forceinline__ int vtr_off(int lane) { const int hi = lane >> 5; return ((lane >> 4) & 1) * 32 + (lane & 3) * 8 + (4 * hi + ((lane & 15) >> 2)) * 64; }

constexpr int MLA_KP = 208;
constexpr int MLA_STAGE = 128 * MLA_KP + 16384;
__device__ __forceinline__ void softmax_pv_vf(WaveAttn& st, f32x16 s, const bf16x8 (&vf)[4]) {
    float mx = s[0];
#pragma unroll
    for (int r = 1; r < 16; ++r) mx = fmaxf(mx, s[r]);
    mx = xhalf_max(mx);
    if (__builtin_amdgcn_ballot_w64(mx > st.m + 8.0f) != 0ull) {
        const float mn = fmaxf(st.m, mx);
        const float alpha = __builtin_amdgcn_exp2f(st.m - mn);
        st.m = mn; st.l *= alpha;
#pragma unroll
        for (int r = 0; r < 16; ++r) { st.o0[r] *= alpha; st.o1[r] *= alpha; }
    }
    const float mn = st.m;
    float ps = 0.f;
#pragma unroll
    for (int r = 0; r < 16; ++r) { s[r] = __builtin_amdgcn_exp2f(s[r] - mn); ps += s[r]; }
    st.l += ps;
    u32x4 p0, p1;
    p0.x = cvtpk(s[0], s[1]); p0.y = cvtpk(s[2], s[3]); p0.z = cvtpk(s[4], s[5]); p0.w = cvtpk(s[6], s[7]);
    p1.x = cvtpk(s[8], s[9]); p1.y = cvtpk(s[10], s[11]); p1.z = cvtpk(s[12], s[13]); p1.w = cvtpk(s[14], s[15]);
    const bf16x8 pb0 = __builtin_bit_cast(bf16x8, p0), pb1 = __builtin_bit_cast(bf16x8, p1);
    st.o0 = __builtin_amdgcn_mfma_f32_32x32x16_bf16(vf[0], pb0, st.o0, 0, 0, 0);
    st.o1 = __builtin_amdgcn_mfma_f32_32x32x16_bf16(vf[2], pb0, st.o1, 0, 0, 0);
    st.o0 = __builtin_amdgcn_mfma_f32_32x32x16_bf16(vf[1], pb1, st.o0, 0, 0, 0);
    st.o1 = __builtin_amdgcn_mfma_f32_32x32x16_bf16(vf[3], pb1, st.o1, 0, 0, 0);
}
__device__ __forceinline__ void mla_phase2(const bf16_t* QKV, bf16_t* O, LAS unsigned char* lds, int nseq, int wv) {
    const int tid = ltid(wv), lane = tid & 63, wave = tid >> 6, r32 = lane & 31, hi = lane >> 5;
    const int voff = vtr_off(lane);
    const int G_ = lgrid(), b_ = lbid(), npair = nseq * 4, nunit = npair * 16;
    for (int u = b_; u < nunit; u += G_) {
        const int sh = (npair == 16) ? ((u & 7) + 8 * ((u >> 3) & 1)) : (u % npair), qb = (npair == 16) ? (u >> 4) : (u / npair);
        const int h = sh & 3, seq = sh >> 2;
        const size_t s0 = (size_t)seq * SEQ;
        const size_t rowa = s0 + qb * 512 + wave * 64 + r32, rowb = rowa + 32;
        bf16x8 qa[6], qb2[6];
#pragma unroll
        for (int ds = 0; ds < 6; ++ds) { qa[ds] = *(const bf16x8*)(QKV + rowa * 1024 + h * 96 + hi * 8 + ds * 16); qb2[ds] = *(const bf16x8*)(QKV + rowb * 1024 + h * 96 + hi * 8 + ds * 16); }
        WaveAttn sta, stb; wa_init(sta); wa_init(stb);
        const bf16_t* kbase = QKV + s0 * 1024 + 384 + h * 96; const bf16_t* vbase = QKV + s0 * 1024 + 768 + h * 64;
        int kso[4], vso[2];
#pragma unroll
        for (int i = 0; i < 4; ++i) { const int o = (wave + 8 * i) * 1024 + 16 * lane, row = o / MLA_KP, cb = o - row * MLA_KP; kso[i] = (row < 128 ? row : 0) * 1024 + (cb < 192 ? cb : 0) / 2; }
#pragma unroll
        for (int i = 0; i < 2; ++i) { const int p = wave + 8 * i; vso[i] = ((p >> 2) * 32 + (p & 1) * 16 + (lane >> 2)) * 1024 + ((p >> 1) & 1) * 32 + (lane & 3) * 8; }
#define MLA_LOAD(kt, buf) do { LAS unsigned char* kb_ = lds + (buf) * MLA_STAGE; LAS unsigned char* vb_ = kb_ + 128 * MLA_KP; \
        _Pragma("unroll") for (int i = 0; i < 4; ++i) if (wave + 8 * i < 26) __builtin_amdgcn_global_load_lds((const unsigned*)(kbase + (size_t)(kt) * 128 * 1024 + kso[i]), (LAS unsigned*)(kb_ + (wave + 8 * i) * 1024), 16, 0, 0); \
        _Pragma("unroll") for (int i = 0; i < 2; ++i) __builtin_amdgcn_global_load_lds((const unsigned*)(vbase + (size_t)(kt) * 128 * 1024 + vso[i]), (LAS unsigned*)(vb_ + (wave + 8 * i) * 1024), 16, 0, 0); } while (0)
        __syncthreads();
        MLA_LOAD(0, 0);
        asm volatile("s_waitcnt vmcnt(0)" ::: "memory"); __syncthreads();
        for (int kt = 0; kt < SEQ / 128; ++kt) {
            if (kt + 1 < SEQ / 128) MLA_LOAD(kt + 1, (kt + 1) & 1);
            LAS const unsigned char* kb = lds + (kt & 1) * MLA_STAGE; LAS const unsigned char* vbuf = kb + 128 * MLA_KP;
#pragma unroll
            for (int sub = 0; sub < 4; ++sub) {
                f32x16 sa, sb;
#pragma unroll
                for (int r = 0; r < 16; ++r) { sa[r] = 0.f; sb[r] = 0.f; }
                LAS const unsigned char* kp = kb + (sub * 32 + r32) * MLA_KP + hi * 16;
                __builtin_amdgcn_s_setprio(1);
#pragma unroll
                for (int ds = 0; ds < 6; ++ds) { const bf16x8 kf = *(LAS const bf16x8*)(kp + ds * 32);
                    sa = __builtin_amdgcn_mfma_f32_32x32x16_bf16(kf, qa[ds], sa, 0, 0, 0); sb = __builtin_amdgcn_mfma_f32_32x32x16_bf16(kf, qb2[ds], sb, 0, 0, 0); }
                __builtin_amdgcn_s_setprio(0);
                LAS const unsigned char* vb_ = vbuf + sub * 4096 + voff;
                bf16x8 vf[4];
#pragma unroll
                for (int i = 0; i < 4; ++i) { const int off = (i >> 1) * 2048 + (i & 1) * 1024; const s16x4 lo_ = vtr(vb_ + off), hi_ = vtr(vb_ + off + 512);
                    vf[i] = (bf16x8){lo_[0], lo_[1], lo_[2], lo_[3], hi_[0], hi_[1], hi_[2], hi_[3]}; }
                softmax_pv_vf(sta, sa, vf); softmax_pv_vf(stb, sb, vf);
            }
            asm volatile("s_waitcnt vmcnt(0)" ::: "memory"); __syncthreads();
        }
#undef MLA_LOAD
        store_o(sta, xhalf_sum(sta.l), O + rowa * 1024 + h * 64, hi);
        store_o(stb, xhalf_sum(stb.l), O + rowb * 1024 + h * 64, hi);
    }
}
__device__ __forceinline__ void mla_phase(const bf16_t* QKV, bf16_t* O, LAS unsigned char* lds, int nseq, int wv) {
    const int tid = ltid(wv), lane = tid & 63, wave = tid >> 6, r32 = lane & 31, hi = lane >> 5;
    const int voff = vtr_off(lane);
    const int G_ = lgrid(), b_ = lbid(), npair = nseq * 4, nunit = npair * 32;
    for (int i_ = 0; i_ * G_ < nunit; ++i_) {
        int sh, qb;
        if (G_ == 256) { sh = (b_ & 7) + 8 * i_; qb = b_ >> 3; } else { const int u = b_ + i_ * G_; sh = u % npair; qb = u / npair; }
        if (sh >= npair || qb >= 32) continue;
        const int h = sh & 3, seq = sh >> 2;
        const size_t s0 = (size_t)seq * SEQ;
        const bf16_t* qrow = QKV + (s0 + qb * 256 + wave * 32 + r32) * 1024 + h * 96 + hi * 8;
        bf16x8 q[6];
#pragma unroll
        for (int ds = 0; ds < 6; ++ds) q[ds] = *(const bf16x8*)(qrow + ds * 16);
        WaveAttn st; wa_init(st);
        const bf16_t* kbase = QKV + s0 * 1024 + 384 + h * 96; const bf16_t* vbase = QKV + s0 * 1024 + 768 + h * 64;
        int kso[4], vso[2];
#pragma unroll
        for (int i = 0; i < 4; ++i) { const int o = (wave + 8 * i) * 1024 + 16 * lane, row = o / MLA_KP, cb = o - row * MLA_KP; kso[i] = (row < 128 ? row : 0) * 1024 + (cb < 192 ? cb : 0) / 2; }
#pragma unroll
        for (int i = 0; i < 2; ++i) { const int p = wave + 8 * i; vso[i] = ((p >> 2) * 32 + (p & 1) * 16 + (lane >> 2)) * 1024 + ((p >> 1) & 1) * 32 + (lane & 3) * 8; }
#define MLA_LOAD(kt, buf) do { LAS unsigned char* kb_ = lds + (buf) * MLA_STAGE; LAS unsigned char* vb_ = kb_ + 128 * MLA_KP; \
        _Pragma("unroll") for (int i = 0; i < 4; ++i) if (wave + 8 * i < 26) __builtin_amdgcn_global_load_lds((const unsigned*)(kbase + (size_t)(kt) * 128 * 1024 + kso[i]), (LAS unsigned*)(kb_ + (wave + 8 * i) * 1024), 16, 0, 0); \
        _Pragma("unroll") for (int i = 0; i < 2; ++i) __builtin_amdgcn_global_load_lds((const unsigned*)(vbase + (size_t)(kt) * 128 * 1024 + vso[i]), (LAS unsigned*)(vb_ + (wave + 8 * i) * 1024), 16, 0, 0); } while (0)
        __syncthreads();
        MLA_LOAD(0, 0);
        asm volatile("s_waitcnt vmcnt(0)" ::: "memory"); __syncthreads();
        for (int kt = 0; kt < SEQ / 128; ++kt) {
            if (kt + 1 < SEQ / 128) MLA_LOAD(kt + 1, (kt + 1) & 1);
            LAS const unsigned char* kb = lds + (kt & 1) * MLA_STAGE; LAS const unsigned char* vbuf = kb + 128 * MLA_KP;
#pragma unroll
            for (int sub = 0; sub < 4; ++sub) {
                f32x16 s;
#pragma unroll
                for (int r = 0; r < 16; ++r) s[r] = 0.f;
                LAS const unsigned char* kp = kb + (sub * 32 + r32) * MLA_KP + hi * 16;
#pragma unroll
                for (int ds = 0; ds < 6; ++ds) { const bf16x8 kf = *(LAS const bf16x8*)(kp + ds * 32); s = __builtin_amdgcn_mfma_f32_32x32x16_bf16(kf, q[ds], s, 0, 0, 0); }
                softmax_pv(st, s, vbuf + sub * 4096 + voff, lane);
            }
            asm volatile("s_waitcnt vmcnt(0)" ::: "memory"); __syncthreads();
        }
#undef MLA_LOAD
        const float lt = xhalf_sum(st.l);
        store_o(st, lt, O + (s0 + qb * 256 + wave * 32 + r32) * 1024 + h * 64, hi);
    }
}

constexpr int LDS_TSWA = 90112  , LDS_TDIL = 95232  , LDS_TNA = 107520  ;
__device__ __forceinline__ void ldk4(bf16x8 (&kf)[4], const bf16_t* rowp) {
#pragma unroll
    for (int ds = 0; ds < 4; ++ds) kf[ds] = *(const bf16x8*)(rowp + ds * 16);
}
__device__ __forceinline__ void stv4(LAS unsigned char* vimg, const u32x4 (&vr)[4], int lane) {
    const int ch = lane & 7;
#pragma unroll
    for (int i = 0; i < 4; ++i) { const int row = (lane >> 3) + 8 * i; *(LAS u32x4*)(vimg + (ch >> 2) * 2048 + row * 64 + (ch & 3) * 16) = vr[i]; }
}
__device__ __forceinline__ f32x16 qk4(const bf16x8 (&kf)[4], const bf16x8 (&q)[4]) {
    f32x16 s;
#pragma unroll
    for (int r = 0; r < 16; ++r) s[r] = 0.f;
#pragma unroll
    for (int ds = 0; ds < 4; ++ds) s = __builtin_amdgcn_mfma_f32_32x32x16_bf16(kf[ds], q[ds], s, 0, 0, 0);
    return s;
}
constexpr float SC64 = 0.125f * LOG2E;

#define SM_TILE_BODY(TA, TB, EDGE) do { \
        bf16x8 kf[4]; u32x4 vr[4]; \
        _Pragma("unroll") for (int i = 0; i < 4; ++i) kf[i] = kfN[i]; \
        SM_LOADV(cur_arg); \
        if (has_next) SM_LOAD(next_arg); \
        f32x16 sa = qk4(kf, qa), sb = qk4(kf, qb); \
        _Pragma("unroll") for (int r = 0; r < 16; ++r) { sa[r] = sa[r] * SC64 + (TA); sb[r] = sb[r] * SC64 + (TB); } \
        EDGE; \
        stv4(vimg, vr, lane); \
        softmax_pv(sta, sa, vimg + voff, lane); softmax_pv(stb, sb, vimg + voff, lane); } while (0)

__device__ __forceinline__ void swa_item(int item, const bf16_t* Z, bf16_t* O, const float* sink, LAS unsigned char* lds, int lane, int wave) {
    const int r32 = lane & 31, hi = lane >> 5, kvh = item & 1, t0 = (item >> 1) * 32, s0 = t0 & ~(SEQ - 1), ha = 2 * kvh;
    LAS unsigned char* vimg = lds + wave * 4096; const int voff = vtr_off(lane);
    LAS const float* taba = (LAS const float*)(lds + LDS_TSWA) + ha * 320 + (4 * hi - r32 + 32);
    LAS const float* tabb = taba + 320;
    const int tq = t0 + r32;
    bf16x8 qa[4], qb[4]; ldk4(qa, Z + (size_t)tq * ZC + COL_C + ha * 64 + hi * 8); ldk4(qb, Z + (size_t)tq * ZC + COL_C + (ha + 1) * 64 + hi * 8);
    WaveAttn sta, stb; wa_init(sta); wa_init(stb);
    int jlo = 0, jhi = 9;
    while (t0 - 128 + 32 * jlo + 31 < s0) ++jlo;
    while (t0 - 128 + 32 * (jhi - 1) >= s0 + SEQ) --jhi;
    const bf16_t* Zk = Z + COL_C + 256 + kvh * 64 + hi * 8; const bf16_t* Zv = Z + COL_C + 384 + kvh * 64 + (lane & 7) * 8;
    bf16x8 kfN[4];
#define SM_LOAD(j_) do { const int kb_ = t0 - 128 + 32 * (j_); ldk4(kfN, Zk + (size_t)clampi(kb_ + r32, s0, s0 + SEQ - 1) * ZC); } while (0)
#define SM_LOADV(j_) do { const int kb_ = t0 - 128 + 32 * (j_); _Pragma("unroll") for (int i = 0; i < 4; ++i) vr[i] = *(const u32x4*)(Zv + (size_t)clampi(kb_ + (lane >> 3) + 8 * i, s0, s0 + SEQ - 1) * ZC); } while (0)
    SM_LOAD(jlo);
    for (int j = jlo; j < jhi; ++j) {
        const int kb = t0 - 128 + 32 * j; const bool has_next = j + 1 < jhi; const int next_arg = j + 1, cur_arg = j;
        LAS const float* tja = taba + 32 * j; LAS const float* tjb = tabb + 32 * j;
        SM_TILE_BODY(tja[(r & 3) + 8 * (r >> 2)], tjb[(r & 3) + 8 * (r >> 2)],
            if (kb < s0 || kb + 31 >= s0 + SEQ) { _Pragma("unroll") for (int r = 0; r < 16; ++r) { const int key = kb + crow(r, hi); if (key < s0 || key >= s0 + SEQ) { sa[r] = NEGBIG; sb[r] = NEGBIG; } } });
    }
#undef SM_LOAD
#undef SM_LOADV
    const float lta = xhalf_sum(sta.l) + __builtin_amdgcn_exp2f(sink[ha] * LOG2E - sta.m);
    const float ltb = xhalf_sum(stb.l) + __builtin_amdgcn_exp2f(sink[ha + 1] * LOG2E - stb.m);
    store_o(sta, lta, O + (size_t)tq * 1024 + 512 + ha * 64, hi);
    store_o(stb, ltb, O + (size_t)tq * 1024 + 512 + (ha + 1) * 64, hi);
}
__device__ __forceinline__ void dil_item(int item, const bf16_t* Z, bf16_t* OD, float* LSE, LAS unsigned char* lds, int lane, int wave, int tg) {
    const int r32 = lane & 31, hi = lane >> 5;
    const int tau = item & 127, slot = (item >> 7) & 3, gs = item >> 9, gi = gs % 3, seq = gs / 3;
    const int dsh = gi * 2, dil = 1 << dsh, sub = SEQ >> dsh, tpr = 128 >> dsh;
    const int res = tau / tpr, m0 = (tau % tpr) * 64, s0 = seq * SEQ;
    LAS unsigned char* vimg = lds + wave * 4096; const int voff = vtr_off(lane);
    LAS const float* taba = (LAS const float*)(lds + LDS_TDIL) + (gi * 4 + slot) * 256 + (4 * hi - r32 + 64);
    LAS const float* tabb = taba - 32;
    const int cq = COL_B + gi * 768 + slot * 64;
    const int tqa = s0 + (m0 + r32) * dil + res, tqb = tqa + 32 * dil;
    bf16x8 qa[4], qb[4]; ldk4(qa, Z + (size_t)tqa * ZC + cq + hi * 8); ldk4(qb, Z + (size_t)tqb * ZC + cq + hi * 8);
    WaveAttn sta, stb; wa_init(sta); wa_init(stb);
    int jlo = 0, jhi = 6;
    while (m0 - 64 + 32 * jlo + 31 < 0) ++jlo;
    while (m0 - 64 + 32 * (jhi - 1) >= sub) --jhi;
    const bf16_t* Zk = Z + (size_t)(s0 + res) * ZC + cq + 256 + hi * 8; const bf16_t* Zv = Z + (size_t)(s0 + res) * ZC + cq + 512 + (lane & 7) * 8;
    bf16x8 kfN[4];
#define SM_LOAD(j_) do { const int mb_ = m0 - 64 + 32 * (j_); ldk4(kfN, Zk + (size_t)(clampi(mb_ + r32, 0, sub - 1) * dil) * ZC); } while (0)
#define SM_LOADV(j_) do { const int mb_ = m0 - 64 + 32 * (j_); _Pragma("unroll") for (int i = 0; i < 4; ++i) vr[i] = *(const u32x4*)(Zv + (size_t)(clampi(mb_ + (lane >> 3) + 8 * i, 0, sub - 1) * dil) * ZC); } while (0)
    SM_LOAD(jlo);
    for (int j = jlo; j < jhi; ++j) {
        const int mb = m0 - 64 + 32 * j; const bool has_next = j + 1 < jhi; const int next_arg = j + 1, cur_arg = j;
        LAS const float* tja = taba + 32 * j; LAS const float* tjb = tabb + 32 * j;
        SM_TILE_BODY(tja[(r & 3) + 8 * (r >> 2)], tjb[(r & 3) + 8 * (r >> 2)],
            if (mb < 0 || mb + 31 >= sub) { _Pragma("unroll") for (int r = 0; r < 16; ++r) { const int mk = mb + crow(r, hi); if (mk < 0 || mk >= sub) { sa[r] = NEGBIG; sb[r] = NEGBIG; } } });
    }
#undef SM_LOAD
#undef SM_LOADV
    const float lta = xhalf_sum(sta.l), ltb = xhalf_sum(stb.l);
    store_o(sta, lta, OD + ((size_t)gi * tg + tqa) * 256 + slot * 64, hi);
    store_o(stb, ltb, OD + ((size_t)gi * tg + tqb) * 256 + slot * 64, hi);
    if (hi == 0) { LSE[((size_t)gi * tg + tqa) * 4 + slot] = sta.m + __builtin_amdgcn_logf(lta); LSE[((size_t)gi * tg + tqb) * 4 + slot] = stb.m + __builtin_amdgcn_logf(ltb); }
}
__device__ __forceinline__ void na_item(int item, const bf16_t* Z, bf16_t* O, LAS unsigned char* lds, int lane, int wave) {
    const int r32 = lane & 31, hi = lane >> 5;
    const int h = item & 3, cb = (item >> 2) & 3, rq = (item >> 4) & 31, seq = item >> 9;
    const int R = 4 * rq, s0 = seq * SEQ, stc = clampi(16 * cb - 8, 0, 32);
    LAS unsigned char* vimg = lds + wave * 4096; const int voff = vtr_off(lane);
    LAS const float* tab = (LAS const float*)(lds + LDS_TNA) + h * 512;
    const int qrowa = R + (r32 >> 4), qrowb = qrowa + 2, qc = 16 * cb + (r32 & 15), tqa = s0 + qrowa * 64 + qc, tqb = tqa + 128;
    const int srqa = clampi(qrowa - 4, 0, 120), srqb = clampi(qrowb - 4, 0, 120), scq = clampi(qc - 8, 0, 48);
    const int cbase = stc + 4 * hi - qc + 15, vbase = stc + 4 * hi - scq;
#define NA_CIDX(r) (((unsigned)(vbase + ((r) & 3) + 8 * ((r) >> 2)) < 16u) ? (cbase + ((r) & 3) + 8 * ((r) >> 2)) : 31)
    bf16x8 qa[4], qb[4]; ldk4(qa, Z + (size_t)tqa * ZC + COL_D + h * 64 + hi * 8); ldk4(qb, Z + (size_t)tqb * ZC + COL_D + h * 64 + hi * 8);
    WaveAttn sta, stb; wa_init(sta); wa_init(stb);
    const int kr0 = clampi(R - 4, 0, 120), kr1 = clampi(R + 3 - 4, 0, 120) + 7;
    const bf16_t* Zk = Z + (size_t)(s0 + stc + r32) * ZC + COL_D + 256 + h * 64 + hi * 8; const bf16_t* Zv = Z + (size_t)(s0 + stc + (lane >> 3)) * ZC + COL_D + 512 + h * 64 + (lane & 7) * 8;
    bf16x8 kfN[4];
#define SM_LOAD(kr_) do { ldk4(kfN, Zk + (size_t)((kr_) * 64) * ZC); } while (0)
#define SM_LOADV(kr_) do { _Pragma("unroll") for (int i = 0; i < 4; ++i) vr[i] = *(const u32x4*)(Zv + (size_t)((kr_) * 64 + 8 * i) * ZC); } while (0)
    SM_LOAD(kr0);
    for (int krow = kr0; krow <= kr1; ++krow) {
        const bool has_next = krow + 1 <= kr1; const int next_arg = krow + 1, cur_arg = krow;
        LAS const float* tra = tab + ((krow >= srqa && krow < srqa + 8) ? clampi(krow - qrowa + 7, 0, 14) : 15) * 32;
        LAS const float* trb = tab + ((krow >= srqb && krow < srqb + 8) ? clampi(krow - qrowb + 7, 0, 14) : 15) * 32;
        SM_TILE_BODY(tra[NA_CIDX(r)], trb[NA_CIDX(r)], (void)0);
    }
#undef SM_LOAD
#undef SM_LOADV
    const float lta = xhalf_sum(sta.l), ltb = xhalf_sum(stb.l);
    store_o(sta, lta, O + (size_t)tqa * 1024 + 768 + h * 64, hi);
    store_o(stb, ltb, O + (size_t)tqb * 1024 + 768 + h * 64, hi);
#undef NA_CIDX
}
#undef SM_TILE_BODY
__device__ __forceinline__ void small_attn_phase(ArgP ap, int layer, const bf16_t* Z, bf16_t* O, bf16_t* OD, float* LSE, LAS unsigned char* lds, int tg, int wv) {
    const int tid = ltid(wv), lane = tid & 63, wave = tid >> 6;
    __syncthreads();
    const float* tgl = (const float*)(ap->ws + WS_TAB);
    for (int i = tid; i < 4 * 320; i += 512) { const int h_ = i / 320, off = i % 320 - 160; ((LAS float*)(lds + LDS_TSWA))[i] = (off >= -128 && off <= 128) ? tgl[h_ * 257 + off + 128] : NEGBIG; }
    for (int i = tid; i < 12 * 256; i += 512) { const int hh = i >> 8, d = (i & 255) - 128; ((LAS float*)(lds + LDS_TDIL))[i] = (d >= -64 && d <= 64) ? tgl[4 * 257 + hh * 129 + d + 64] : NEGBIG; }
    const float* rpb = ap->in[I_RPB] + (size_t)layer * 4 * 465;
    for (int i = tid; i < 4 * 512; i += 512) { const int h_ = i >> 9, rr = (i >> 5) & 15, cc = i & 31; ((LAS float*)(lds + LDS_TNA))[i] = (rr < 15 && cc < 31) ? rpb[h_ * 465 + rr * 31 + cc] * LOG2E : NEGBIG; }
    __syncthreads();
    const int G_ = lgrid(), b_ = lbid(), vb = (G_ % 8 == 0) ? (b_ % 8) * (G_ / 8) + b_ / 8 : b_;
    const int gw = vb * 8 + wave, NGW = G_ * 8;
    const float* sink = ap->in[I_SINK] + layer * 4;
    const int nseq = tg / SEQ, n_dil = nseq * 1536, n_swa = nseq * 512, n_na = nseq * 512;
    for (int it = gw; it < n_dil + n_swa + n_na; it += NGW) {
        if (it < n_dil) dil_item(it, Z, OD, LSE, lds, lane, wave, tg);
        else if (it < n_dil + n_swa) swa_item(it - n_dil, Z, O, sink, lds, lane, wave);
        else na_item(it - n_dil - n_swa, Z, O, lds, lane, wave);
    }
}

__device__ __forceinline__ void branch_phase(LAS unsigned char* lds, const bf16_t* __restrict__ O, const bf16_t* __restrict__ Wb, const bf16_t* __restrict__ Gt, bf16_t* __restrict__ MG, int tg, int wv) {
    const int tid = ltid(wv), lane = tid & 63, wave = tid >> 6, wm = wave >> 2, wn = wave & 3, fr = lane & 15, fq = lane >> 4;
    const int G_ = lgrid(), b_ = lbid(), vb = (G_ % 8 == 0) ? (b_ % 8) * (G_ / 8) + b_ / 8 : b_;
    const int ntile = (tg / 128) * 4;
    constexpr int STG = 49152;
    int pR[2], pC[2];
#pragma unroll
    for (int i = 0; i < 2; ++i) pg8::stage_rc(tid * 16 + i * 8192, pR[i], pC[i]);
    const int aoff = pg8::lds_byte(wm * 64 + fr, fq * 8), boff = 16384 + (wn >> 1) * 16384 + pg8::lds_byte((wn & 1) * 64 + fr, fq * 8);
    __syncthreads();
    for (int tile = vb; tile < ntile; tile += G_) {
        const int rt = tile >> 2, ct = tile & 3;
        const bf16_t* Ab = O + (size_t)(rt * 128) * 1024;
        u32x2 sum[4][4];
#pragma unroll
        for (int m = 0; m < 4; ++m)
#pragma unroll
            for (int n = 0; n < 4; ++n) sum[m][n] = (u32x2){0u, 0u};
#define BR_LOAD(c_, s_) do { const int j_ = (c_) >> 2, kc_ = (c_) & 3; LAS unsigned char* sb_ = lds + (s_) * STG + wave * 1024; \
        _Pragma("unroll") for (int i = 0; i < 2; ++i) { \
            __builtin_amdgcn_global_load_lds((const unsigned*)(Ab + (size_t)pR[i] * 1024 + j_ * 256 + kc_ * 64 + pC[i]), (LAS unsigned*)(sb_ + i * 8192), 16, 0, 0); \
            __builtin_amdgcn_global_load_lds((const unsigned*)(Wb + (size_t)(j_ * 1024 + ct * 256 + pR[i]) * 256 + kc_ * 64 + pC[i]), (LAS unsigned*)(sb_ + 16384 + i * 8192), 16, 0, 0); \
            __builtin_amdgcn_global_load_lds((const unsigned*)(Wb + (size_t)(j_ * 1024 + ct * 256 + 128 + pR[i]) * 256 + kc_ * 64 + pC[i]), (LAS unsigned*)(sb_ + 32768 + i * 8192), 16, 0, 0); } } while (0)
        BR_LOAD(0, 0);
        asm volatile("s_waitcnt vmcnt(0)" ::: "memory"); __syncthreads();
        for (int j = 0; j < 4; ++j) {
            u32x2 gv[4][4];
            f32x4 acc[4][4];
#pragma unroll
            for (int m = 0; m < 4; ++m)
#pragma unroll
                for (int n = 0; n < 4; ++n) acc[m][n] = (f32x4){0.f, 0.f, 0.f, 0.f};
            for (int kc = 0; kc < 4; ++kc) {
                const int c = j * 4 + kc;
                if (c + 1 < 16) BR_LOAD(c + 1, (c + 1) & 1);
                if (kc == 3) {
                    const bf16_t* gp = Gt + (size_t)(rt * 128 + wm * 64 + fr) * ZC + j * 1024 + ct * 256 + wn * 64 + 4 * fq;
#pragma unroll
                    for (int m = 0; m < 4; ++m)
#pragma unroll
                        for (int n = 0; n < 4; ++n) gv[m][n] = *(const u32x2*)(gp + (size_t)m * 16 * ZC + n * 16);
                }
                LAS const unsigned char* st = lds + (c & 1) * STG;
#pragma unroll
                for (int k = 0; k < 2; ++k) {
                    __builtin_amdgcn_sched_barrier(0);
                    bf16x8 af[4], bfr[4];
#pragma unroll
                    for (int m = 0; m < 4; ++m) af[m] = *(LAS const bf16x8*)(st + aoff + m * 2048 + k * 1024);
#pragma unroll
                    for (int n = 0; n < 4; ++n) bfr[n] = *(LAS const bf16x8*)(st + boff + n * 2048 + k * 1024);
#pragma unroll
                    for (int m = 0; m < 4; ++m)
#pragma unroll
                        for (int n = 0; n < 4; ++n) acc[m][n] = __builtin_amdgcn_mfma_f32_16x16x32_bf16(bfr[n], af[m], acc[m][n], 0, 0, 0);
                }
                asm volatile("s_waitcnt vmcnt(0)" ::: "memory"); __syncthreads();
            }
#pragma unroll
            for (int m = 0; m < 4; ++m)
#pragma unroll
                for (int n = 0; n < 4; ++n) { const u32x2 g = gv[m][n], sp = sum[m][n];
                    const float s0_ = __builtin_bit_cast(float, sp.x << 16) + acc[m][n][0] * __builtin_bit_cast(float, g.x << 16), s1_ = __builtin_bit_cast(float, sp.x & 0xffff0000u) + acc[m][n][1] * __builtin_bit_cast(float, g.x & 0xffff0000u);
                    const float s2_ = __builtin_bit_cast(float, sp.y << 16) + acc[m][n][2] * __builtin_bit_cast(float, g.y << 16), s3_ = __builtin_bit_cast(float, sp.y & 0xffff0000u) + acc[m][n][3] * __builtin_bit_cast(float, g.y & 0xffff0000u);
                    sum[m][n] = (u32x2){cvtpk(s0_, s1_), cvtpk(s2_, s3_)}; }
        }
#undef BR_LOAD
#pragma unroll
        for (int m = 0; m < 4; ++m)
#pragma unroll
            for (int n = 0; n < 4; ++n) { const u32x2 w = sum[m][n];
                *(u32x2*)(MG + (size_t)(rt * 128 + wm * 64 + m * 16 + fr) * 1024 + ct * 256 + wn * 64 + n * 16 + 4 * fq) = w; }
    }
}

#define XB_TMO      128
#define XB_XCNT(j)  (256  + 64 * (j))
#define XB_XSUB(j)  (1280 + 64 * (j))
#define XB_XGEN(j)  (2304 + 64 * (j))
#define XB_TOP      3328
#define XB_TOPGEN   3392
#define XCD_BAR_WORDS 3456
#define XB_SPIN_CAP (1u << 18)
__device__ __forceinline__ unsigned xb_ld(unsigned* p)              { return __hip_atomic_load(p, __ATOMIC_RELAXED, __HIP_MEMORY_SCOPE_AGENT); }
__device__ __forceinline__ unsigned xb_add(unsigned* p, unsigned v) { return __hip_atomic_fetch_add(p, v, __ATOMIC_RELAXED, __HIP_MEMORY_SCOPE_AGENT); }
__device__ __forceinline__ unsigned xb_xcc_id() { return (unsigned)__builtin_amdgcn_s_getreg((3 << 11) | 20) & 0xFu; }
#define XB_SPIN(cond, bar) do { unsigned _sp = 0; while (cond) { __builtin_amdgcn_s_sleep(1); \
    if ((++_sp & 255u) == 0u) { if (xb_ld(&(bar)[XB_TMO])) break; if (_sp > XB_SPIN_CAP) { atomicAdd(&(bar)[XB_TMO], 1u); break; } } } } while (0)
__device__ __forceinline__ void xcd_barrier_complete(unsigned* bar, unsigned x, unsigned G, unsigned& nloc, unsigned& nx) {
    unsigned sum, cnt, mine, sp = 0u;
    for (;;) {
        sum = 0u; cnt = 0u; mine = 0u;
#pragma unroll
        for (unsigned j = 0; j < 16; ++j) { const unsigned c = xb_ld(&bar[XB_XCNT(j)]); sum += c; cnt += (c > 0u) ? 1u : 0u; mine = (j == x) ? c : mine; }
        if (sum == G) break;
        __builtin_amdgcn_s_sleep(1);
        if ((++sp & 255u) == 0u) { if (xb_ld(&bar[XB_TMO])) break; if (sp > XB_SPIN_CAP) { atomicAdd(&bar[XB_TMO], 1u); break; } }
    }
    nloc = mine > 0u ? mine : 1u; nx = cnt > 0u ? cnt : 1u;
}
__device__ __forceinline__ void xcd_barrier(unsigned* bar, volatile LAS unsigned* st, int tid) {
    asm volatile("s_waitcnt vmcnt(0)" ::: "memory");
    __syncthreads();
    if (tid == 0) {
        __builtin_amdgcn_s_waitcnt(0);
        const unsigned x = xb_xcc_id();
        unsigned nloc = st[0], nx = st[1];
        if (nloc == 0u) { xcd_barrier_complete(bar, x, (unsigned)lgrid(), nloc, nx); st[0] = nloc; st[1] = nx; }
        const unsigned old = xb_add(&bar[XB_XSUB(x)], 1u);
        const unsigned gen = old / nloc;
        if (old + 1u == (gen + 1u) * nloc) {
            __builtin_amdgcn_fence(__ATOMIC_RELEASE, "agent");
            asm volatile("s_waitcnt vmcnt(0)" ::: "memory");
            const unsigned og = xb_add(&bar[XB_TOP], 1u);
            const unsigned tg = og / nx;
            if (og + 1u == (tg + 1u) * nx) xb_add(&bar[XB_TOPGEN], 1u);
            else XB_SPIN(xb_ld(&bar[XB_TOPGEN]) == tg, bar);
            __builtin_amdgcn_fence(__ATOMIC_ACQUIRE, "agent");
            xb_add(&bar[XB_XGEN(x)], 1u);
            asm volatile("s_waitcnt vmcnt(0)" ::: "memory");
        } else {
            XB_SPIN(xb_ld(&bar[XB_XGEN(x)]) == gen, bar);
            __builtin_amdgcn_fence(__ATOMIC_ACQUIRE, "agent");
            asm volatile("s_waitcnt vmcnt(0)" ::: "memory");
        }
    }
    __syncthreads();
}

constexpr int LDS_BYTES = 147456;
constexpr int PH_PER = 16;
constexpr int N_STEPS = 1 + NGROUP * DEPTH * PH_PER;

#ifndef ONLYM
#define ONLYM 0x1ffff
#endif
__global__ void __launch_bounds__(512, 2) fwd_kernel(Args a) {
    extern __shared__ __attribute__((aligned(16))) unsigned char lds_raw[];
    LAS unsigned char* lds = (LAS unsigned char*)lds_raw;
    cg::grid_group grid = cg::this_grid();
#define CASE(n) case n: if constexpr ((ONLYM >> (n)) & 1)
    const int s_lo = a.lo, s_hi = a.hi;
    const int wv = __builtin_amdgcn_readfirstlane((int)threadIdx.x >> 6);
    volatile LAS unsigned* bst = (volatile LAS unsigned*)(lds + 131072 + 1024);
    if (ltid(wv) == 0) { bst[0] = 0u; bst[1] = 0u; (void)xb_add((unsigned*)(a.ws + WS_BAR) + XB_XCNT(xb_xcc_id()), 1u); }
    __syncthreads();
    if (s_lo == 0) {
        ArgP ap0 = (ArgP)__builtin_amdgcn_kernarg_segment_ptr(); asm volatile("" : "+s"(ap0));
        if constexpr ((ONLYM >> 16) & 1) prologue(ap0, lds, wv);
        if (s_hi > 1) grid.sync();
    }
    for (int s = (s_lo > 1 ? s_lo : 1); s < s_hi; ++s) {
        const int G = lgrid();
        ArgP ap = (ArgP)__builtin_amdgcn_kernarg_segment_ptr(); asm volatile("" : "+s"(ap));
        unsigned char* ws = ap->ws;
        {
            const int idx = s - 1, ph = idx & 15, L = (idx >> 4) & 3, g = idx >> 6;
            if ((ph == 15 && L != DEPTH - 1) || (ph == 0 && L != 0) || ph == 2 || ph == 8 || ph == 12 || ph == 13) continue;
            const int tg = g < 2 ? TGM : NTOK - 2 * TGM;
            float* X = ap->out + (size_t)g * TGM * DM;
            unsigned char* wl = ws + WS_W + (size_t)L * WL_SIZE;
            switch (ph) {
            CASE(0) {
                const float* xin = (g < 2) ? ap->in[I_XP] + (size_t)g * TGM * DM : ap->in[I_XS];
                intake_rows(xin, X, (bf16_t*)(ws + WS_H), (float*)(ws + WS_RS), tg, wv);
                const float* psrc = ap->in[I_PP]; (void)psrc; } break;
            CASE(1) {
                pg8::Gemm gm{(const bf16_t*)(ws + WS_H), (const bf16_t*)(wl + WL_CAT), 1024, 1024, 1024}; pg8::StaticOrder S; S.init(tg, 4096, G, lbid());
                pg8::EpiBf16 E{(bf16_t*)(ws + WS_Z), (bf16_t*)(ws + WS_Z), ZC, 1 << 30, (const float*)(ws + WS_RS), (float*)(ws + WS_RSM)}; pg8::gemm_phase(lds, gm, S, E, wv); } break;
            CASE(2) {
                } break;
            CASE(3) {
                const float* rcos = (const float*)(ws + WS_ROPE);
                pg8::Gemm gm{(const bf16_t*)(ws + WS_Z), (const bf16_t*)(wl + WL_MLA), ZC, 512, 512}; pg8::StaticOrder S; S.init(tg, 1024, G, lbid());
                pg8::EpiMla E{(bf16_t*)(ws + WS_QKV), rcos, rcos + SEQ * 16, 0.10206207261596577f * LOG2E, (const float*)(ws + WS_RSM)}; pg8::gemm_phase(lds, gm, S, E, wv); } break;
            CASE(4) {
                if (tg / SEQ >= 4) mla_phase2((const bf16_t*)(ws + WS_QKV), (bf16_t*)(ws + WS_O), lds, tg / SEQ, wv);
                else mla_phase((const bf16_t*)(ws + WS_QKV), (bf16_t*)(ws + WS_O), lds, tg / SEQ, wv);
                small_attn_phase(ap, L, (const bf16_t*)(ws + WS_Z), (bf16_t*)(ws + WS_O), (bf16_t*)(ws + WS_OD), (float*)(ws + WS_LSE), lds, tg, wv); } break;
            CASE(5) {
                pg8::Gemm gm{(const bf16_t*)(ws + WS_H), (const bf16_t*)(wl + WL_CAT) + (size_t)4096 * 1024, 1024, 1024, 1024}; pg8::StaticOrder S; S.init(tg, 4096, G, lbid());
                pg8::EpiBf16 E{(bf16_t*)(ws + WS_G), (bf16_t*)(ws + WS_G), ZC, 0, (const float*)(ws + WS_RS)}; pg8::gemm_phase(lds, gm, S, E, wv);
                for (int r0 = lbid() * 128; r0 < tg; r0 += G * 128) dil_combine((const bf16_t*)(ws + WS_OD), (const float*)(ws + WS_LSE), (bf16_t*)(ws + WS_O), r0, 128, tg, wv); } break;
            CASE(6) {
                branch_phase(lds, (const bf16_t*)(ws + WS_O), (const bf16_t*)(wl + WL_B), (const bf16_t*)(ws + WS_G), (bf16_t*)(ws + WS_MG), tg, wv); } break;
            CASE(7) {
                pg8::Gemm gm{(const bf16_t*)(ws + WS_MG), (const bf16_t*)(wl + WL_OUT), 1024, 1024, 1024}; pg8::StaticOrder S; S.init(tg, 1024, G, lbid());
                pg8::EpiResid E{X, nullptr, nullptr, (bf16_t*)(ws + WS_H), (float*)(ws + WS_RS) + (size_t)TGM * 16}; pg8::gemm_phase(lds, gm, S, E, wv);
                const float* psrc = (g < 2) ? ap->in[I_PP] + ((size_t)L * NPROMPT + (size_t)g * TGM) * 256 : ap->in[I_PS] + (size_t)L * (NTOK - NPROMPT) * 256;
                cvt_p(psrc, (bf16_t*)(ws + WS_PB), tg, wv); } break;
            CASE(8) {
                } break;
            CASE(9) {
                pg8::Gemm gm{(const bf16_t*)(ws + WS_H), (const bf16_t*)(wl + WL_UP), 1024, 1024, 1024}; pg8::StaticOrder S; S.init(tg, DFF2, G, lbid());
                pg8::EpiBf16 E{(bf16_t*)(ws + WS_U), (bf16_t*)(ws + WS_U), DFF2, 1 << 30, (const float*)(ws + WS_RS) + (size_t)TGM * 16}; pg8::gemm_phase(lds, gm, S, E, wv);
                __syncthreads();
                pg8::Gemm gm2{(const bf16_t*)(ws + WS_PB), (const bf16_t*)(wl + WL_PP), 256, 256, 256}; pg8::StaticOrder S2; S2.init(tg, 1024, G, lbid());
                pg8::EpiBf16 E2{(bf16_t*)(ws + WS_PP), (bf16_t*)(ws + WS_PP), 1024, 1 << 30, nullptr}; pg8::gemm_phase(lds, gm2, S2, E2, wv); } break;
            CASE(10) {
                conv_pass((const bf16_t*)(ws + WS_U), ap->in[I_CW] + (size_t)L * 3 * DFF2, ap->in[I_CB] + (size_t)L * DFF2, (bf16_t*)(ws + WS_GA), tg, wv); } break;
            CASE(11) {
                pg8::Gemm gm{(const bf16_t*)(ws + WS_GA), (const bf16_t*)(wl + WL_DOWN), DFF, DFF, DFF}; pg8::StaticOrder S; S.init(tg, 1024, G, lbid());
                pg8::EpiResid E{X, nullptr, nullptr, (bf16_t*)(ws + WS_H1), (float*)(ws + WS_RS) + (size_t)2 * TGM * 16}; pg8::gemm_phase(lds, gm, S, E, wv); } break;
            CASE(12) {
                } break;
            CASE(13) { } break;
            CASE(14) {
                pg8::Gemm gm{(const bf16_t*)(ws + WS_H1), (const bf16_t*)(wl + WL_PG), 1024, 1024, 1024}; pg8::StaticOrder S; S.init(tg, 1024, G, lbid());
                pg8::EpiResid E{X, (const bf16_t*)(ws + WS_PP), (const float*)(ws + WS_RS) + (size_t)2 * TGM * 16, (bf16_t*)(ws + WS_H), (float*)(ws + WS_RS)}; pg8::gemm_phase(lds, gm, S, E, wv); } break;
            CASE(15) {
                final_norm_rows(X, ap->in[I_LNFIN], tg, wv); } break;
            default: break;
            }
        }
        if (s + 1 < s_hi) xcd_barrier((unsigned*)(ap->ws + WS_BAR), bst, ltid(wv));
    }
#undef CASE
}

#ifndef MK_MULTI
#define MK_MULTI 0
#endif
extern "C" void kernel_launch(void* const* d_in, const int* in_sizes, int n_in, void* d_out, int out_size, void* d_ws, size_t ws_size, hipStream_t stream) {
    static int grid = 0;
    if (grid == 0) {
        if (n_in != 25 || out_size != NTOK * DM || ws_size < WS_END) { fprintf(stderr, "kernel_launch: unexpected shapes (n_in %d out %d ws %zu)\n", n_in, out_size, ws_size); grid = -1; return; }
        int dev = 0, cus = 0, per_cu = 0;
        hipGetDevice(&dev); hipDeviceGetAttribute(&cus, hipDeviceAttributeMultiprocessorCount, dev);
        if (hipFuncSetAttribute((const void*)fwd_kernel, hipFuncAttributeMaxDynamicSharedMemorySize, LDS_BYTES) != hipSuccess) { fprintf(stderr, "kernel_launch: hipFuncSetAttribute failed\n"); grid = -1; return; }
        hipOccupancyMaxActiveBlocksPerMultiprocessor(&per_cu, (const void*)fwd_kernel, 512, LDS_BYTES);
        (void)hipGetLastError();
        if (per_cu < 1) { fprintf(stderr, "kernel_launch: occupancy query says %d blocks/CU\n", per_cu); per_cu = 1; }
        grid = cus;
    }
    if (grid < 0) return;
    if (hipMemsetAsync((char*)d_ws + WS_BAR, 0, WS_BAR_BYTES, stream) != hipSuccess) { fprintf(stderr, "kernel_launch: memset failed\n"); return; }
    Args a{};
    for (int i = 0; i < 25; ++i) a.in[i] = (const float*)d_in[i];
    a.out = (float*)d_out; a.ws = (unsigned char*)d_ws;
#if MK_MULTI
    for (int s = 0; s < N_STEPS; ++s) { a.lo = s; a.hi = s + 1; hipLaunchKernelGGL(fwd_kernel, dim3(grid), dim3(512), LDS_BYTES, stream, a); }
#else
    a.lo = 0; a.hi = N_STEPS;
    void* args[] = {&a};
    hipError_t e = hipLaunchCooperativeKernel((const void*)fwd_kernel, dim3(grid), dim3(512), args, LDS_BYTES, stream);
    if (e != hipSuccess) fprintf(stderr, "kernel_launch: cooperative launch failed: %s (grid %d)\n", hipGetErrorString(e), grid);
#endif
}
```
